# Optimizing an MI355X kernel written in HIP

```python
import jax, jax.numpy as jnp
from jax import lax
import numpy as np

D_MODEL = 1024
BATCH = 2
SEQ = 8192
DEPTH = 2

CONV_CH = D_MODEL // 2
CONV_WIDTH = 31
N_HEADS = 8
HEAD_DIM = 64
ATTN_WIDTH = N_HEADS * HEAD_DIM
D_FF = ((8 * D_MODEL // 3 + 255) // 256) * 256
Q_BLOCK = 128
EPS = 1e-6

COL_SIZES = (2 * CONV_CH,
             ATTN_WIDTH,
             ATTN_WIDTH,
             ATTN_WIDTH,
             N_HEADS,
             D_MODEL,
             D_MODEL)
IN_COLS = sum(COL_SIZES)
COL_SPLITS = tuple(int(s) for s in np.cumsum(COL_SIZES)[:-1])

kernel_name = "hybrid_conformer_conv_fox_attention_swiglu"


def rmsnorm(x, g):
    xf = x.astype(jnp.float32)
    inv = lax.rsqrt(jnp.mean(xf * xf, axis=-1, keepdims=True) + EPS)
    return (xf * inv).astype(x.dtype) * g


def layernorm(x, g, b):
    xf = x.astype(jnp.float32)
    mu = jnp.mean(xf, axis=-1, keepdims=True)
    var = jnp.mean(jnp.square(xf - mu), axis=-1, keepdims=True)
    return ((xf - mu) * lax.rsqrt(var + EPS)).astype(x.dtype) * g + b


def causal_depthwise_conv(a, w, b):
    out = lax.conv_general_dilated(
        a, w[:, None, :], window_strides=(1,), padding=[(CONV_WIDTH - 1, 0)],
        dimension_numbers=("NWC", "WIO", "NWC"), feature_group_count=CONV_CH)
    return out + b


def conformer_conv_branch(a_in, w_dw, b_dw, g_ln, b_ln, w_out):
    a = a_in[..., :CONV_CH] * jax.nn.sigmoid(a_in[..., CONV_CH:])
    a = causal_depthwise_conv(a, w_dw, b_dw)
    a = jax.nn.silu(layernorm(a, g_ln, b_ln))
    return a @ w_out


def forgetting_attention(q, k, v, f_logit, b_forget, g_q, g_k):
    B, S, _ = q.shape
    nb = S // Q_BLOCK
    def heads(t, g):
        t = t.reshape(B, S, N_HEADS, HEAD_DIM)
        if g is not None:
            t = rmsnorm(t, g)
        return t.transpose(0, 2, 1, 3)
    qh, kh, vh = heads(q, g_q), heads(k, g_k), heads(v, None)
    log_f = jax.nn.log_sigmoid(f_logit.astype(jnp.float32) + b_forget.astype(jnp.float32))
    c = jnp.cumsum(log_f, axis=1).transpose(0, 2, 1)
    scale = HEAD_DIM ** -0.5
    q_blocks = qh.reshape(B, N_HEADS, nb, Q_BLOCK, HEAD_DIM).transpose(2, 0, 1, 3, 4)
    c_blocks = c.reshape(B, N_HEADS, nb, Q_BLOCK).transpose(2, 0, 1, 3)
    k_pos = jnp.arange(S)

    def one_block(args):
        qi, ci, i = args
        s = jnp.einsum("bhqd,bhkd->bhqk", qi, kh).astype(jnp.float32) * scale
        s = s + ci[..., :, None] - c[:, :, None, :]
        q_pos = i * Q_BLOCK + jnp.arange(Q_BLOCK)
        s = jnp.where(k_pos[None, :] <= q_pos[:, None], s, -jnp.inf)
        p = jax.nn.softmax(s, axis=-1).astype(vh.dtype)
        return jnp.einsum("bhqk,bhkd->bhqd", p, vh)

    out = lax.map(one_block, (q_blocks, c_blocks, jnp.arange(nb)))
    return out.transpose(1, 0, 3, 2, 4).reshape(B, S, ATTN_WIDTH)


def setup_inputs(seed: int = 0) -> dict:
    key = jax.random.key(seed)
    ks = jax.random.split(key, 20)
    f32 = jnp.float32
    def nrm(k, shape, fan_in):
        return jax.random.normal(k, shape, f32) * fan_in ** -0.5
    def gain(k, shape):
        return 1.0 + 0.02 * jax.random.normal(k, shape, f32)
    return {
        "x": jax.random.normal(ks[0], (BATCH, SEQ, D_MODEL), f32),
        "g_mix": gain(ks[1], (DEPTH, D_MODEL)),
        "w_in": nrm(ks[2], (DEPTH, D_MODEL, IN_COLS), D_MODEL),
        "b_forget": jax.random.uniform(ks[3], (DEPTH, N_HEADS), f32, 2.0, 5.0),
        "w_dw": nrm(ks[4], (DEPTH, CONV_WIDTH, CONV_CH), CONV_WIDTH),
        "b_dw": 0.02 * jax.random.normal(ks[5], (DEPTH, CONV_CH), f32),
        "g_conv_ln": gain(ks[6], (DEPTH, CONV_CH)),
        "b_conv_ln": 0.02 * jax.random.normal(ks[7], (DEPTH, CONV_CH), f32),
        "w_conv_out": nrm(ks[8], (DEPTH, CONV_CH, D_MODEL), CONV_CH),
        "g_q": gain(ks[9], (DEPTH, HEAD_DIM)),
        "g_k": gain(ks[10], (DEPTH, HEAD_DIM)),
        "w_attn_out": nrm(ks[11], (DEPTH, ATTN_WIDTH, D_MODEL), ATTN_WIDTH),
        "w_out": nrm(ks[12], (DEPTH, D_MODEL, D_MODEL), D_MODEL),
        "g_ffn": gain(ks[13], (DEPTH, D_MODEL)),
        "w_ffn_in": nrm(ks[14], (DEPTH, D_MODEL, 2 * D_FF), D_MODEL),
        "w_ffn_out": nrm(ks[15], (DEPTH, D_FF, D_MODEL), D_FF),
    }


def reference(x, g_mix, w_in, b_forget, w_dw, b_dw, g_conv_ln, b_conv_ln, w_conv_out,
              g_q, g_k, w_attn_out, w_out, g_ffn, w_ffn_in, w_ffn_out):
    for l in range(DEPTH):
        h = rmsnorm(x, g_mix[l])
        proj = h @ w_in[l]
        a_in, q, k, v, f_logit, gate_a, gate_b = jnp.split(proj, COL_SPLITS, axis=-1)
        y_conv = conformer_conv_branch(a_in, w_dw[l], b_dw[l], g_conv_ln[l],
                                       b_conv_ln[l], w_conv_out[l])
        y_attn = forgetting_attention(q, k, v, f_logit, b_forget[l], g_q[l], g_k[l]) @ w_attn_out[l]
        merged = jax.nn.sigmoid(gate_a) * y_conv + jax.nn.sigmoid(gate_b) * y_attn
        x = x + merged @ w_out[l]
        h2 = rmsnorm(x, g_ffn[l])
        gu = h2 @ w_ffn_in[l]
        x = x + (jax.nn.silu(gu[..., :D_FF]) * gu[..., D_FF:]) @ w_ffn_out[l]
    return x
```

```cpp
#include <hip/hip_runtime.h>
#include <cstdio>
#include <cstdint>
namespace pg8 {
#define PG8_LAS __attribute__((address_space(3)))
typedef unsigned short bf16_t;
typedef short bf16x8 __attribute__((ext_vector_type(8)));
typedef float f32x4 __attribute__((ext_vector_type(4)));
typedef unsigned u32x4 __attribute__((ext_vector_type(4)));
constexpr int BM = 256, BK = 64, HALF = 128, HTB = HALF * BK * 2  , STAGE_BYTES = 8 * HTB, NXCD = 8, WGM = 8;

__host__ __device__ __forceinline__ int lds_byte(int r, int c) { const int st = (r >> 4) * 2 + (c >> 5), rr = r & 15, cc = c & 31, ob = rr * 64 + cc * 2; return st * 1024 + (ob ^ (((ob >> 9) & 1) << 5)); }
__host__ __device__ __forceinline__ void stage_rc(int b, int& R, int& C) { const int st = b / 1024, sb = b % 1024, swz = sb ^ (((sb >> 9) & 1) << 5); R = (st >> 1) * 16 + swz / 64; C = (st & 1) * 32 + (swz % 64) / 2; }
__host__ __device__ __forceinline__ int perm32(int rho) { const int n = rho >> 4, i = rho & 15; return 8 * (i >> 2) + 4 * n + (i & 3); }

struct Unit { int pm, pn; };
struct Gemm { const bf16_t* A; const bf16_t* Bt; int M, N, K; };

struct StaticOrder {
    int nM, nN, nwg, G, c;
    __host__ __device__ void init(int M, int N, int G_, int c_) { nM = M / BM; nN = N / BM; nwg = nM * nN; G = G_; c = c_; }
    __host__ __device__ bool next(int i, Unit& u) const {
        const long L = (long)i * G + c; if (L >= nwg) return false;
        int wgid = (int)L; { const int q = nwg / NXCD, r = nwg % NXCD, xcd = wgid % NXCD, off = wgid / NXCD; wgid = (xcd < r ? xcd * (q + 1) : r * (q + 1) + (xcd - r) * q) + off; }
        const int nig = WGM * nN, gid = wgid / nig, fm = gid * WGM, gsz = (nM - fm) < WGM ? (nM - fm) : WGM;
        u.pm = fm + ((wgid % nig) % gsz); u.pn = (wgid % nig) / gsz; return true;
    }
    __device__ __forceinline__ void a_ready(const Unit&) const {}
    __device__ __forceinline__ void done(const Unit&) const {}
};

typedef float f32x2cv __attribute__((ext_vector_type(2))); typedef __bf16 bf16x2cv __attribute__((ext_vector_type(2)));
__device__ __forceinline__ unsigned cvt_pk_bf16(float lo, float hi) { const f32x2cv v = {lo, hi}; const bf16x2cv b = __builtin_convertvector(v, bf16x2cv); return __builtin_bit_cast(unsigned, b); }
typedef float f32x2 __attribute__((ext_vector_type(2)));
typedef float f32x2 __attribute__((ext_vector_type(2)));
__device__ __forceinline__ float bf_lo(unsigned u) { return __uint_as_float(u << 16); }
__device__ __forceinline__ float bf_hi(unsigned u) { return __uint_as_float(u & 0xffff0000u); }
__device__ __forceinline__ float sigm(float x) { return __builtin_amdgcn_rcpf(1.0f + __expf(-x)); }
__device__ __forceinline__ u32x4 pack8(const f32x4 a, const f32x4 b) { u32x4 w; w.x = cvt_pk_bf16(a[0], a[1]); w.y = cvt_pk_bf16(a[2], a[3]); w.z = cvt_pk_bf16(b[0], b[1]); w.w = cvt_pk_bf16(b[2], b[3]); return w; }
__device__ __forceinline__ void unpack8(const u32x4 w, f32x4& a, f32x4& b) { a = (f32x4){bf_lo(w.x), bf_hi(w.x), bf_lo(w.y), bf_hi(w.y)}; b = (f32x4){bf_lo(w.z), bf_hi(w.z), bf_lo(w.w), bf_hi(w.w)}; }
__device__ __forceinline__ float row_inv(const float* ss, int row) {
    const f32x4* p = (const f32x4*)(ss + (size_t)row * 16);
    const f32x4 a = p[0], b = p[1], c = p[2], d = p[3];
    const float s = (((a[0] + a[1]) + (a[2] + a[3])) + ((b[0] + b[1]) + (b[2] + b[3]))) + (((c[0] + c[1]) + (c[2] + c[3])) + ((d[0] + d[1]) + (d[2] + d[3])));
    return __builtin_amdgcn_rsqf(s * (1.0f / 1024.0f) + 1e-6f);
}

struct EpiGateSig {
    static constexpr bool PERM = true, AFTER_DRAIN = false;
    const float* ss; bf16_t *GA, *GB;
    __device__ __forceinline__ void operator()(const f32x4 (&acc)[2][2][4][2], const Unit& u, int wr, int wc, int fr, int fq) const {
        const int p = u.pn; const int rowb = u.pm * BM + wr * 64 + fr;
        bf16_t* O = p < 4 ? GA : GB; const int cb = (p & 3) * 256;
#pragma unroll
        for (int ai = 0; ai < 2; ++ai)
#pragma unroll
            for (int m = 0; m < 4; ++m) { const int row = rowb + ai * HALF + m * 16; const float inv = row_inv(ss, row);
#pragma unroll
                for (int bj = 0; bj < 2; ++bj) { f32x4 o[2];
#pragma unroll
                    for (int n = 0; n < 2; ++n) { const f32x4 v = acc[ai][bj][m][n] * inv;
#pragma unroll
                        for (int e = 0; e < 4; ++e) o[n][e] = sigm(v[e]); }
                    *(u32x4*)(O + (size_t)row * 1024 + cb + bj * HALF + wc * 32 + fq * 8) = pack8(o[0], o[1]); } }
    }
};
struct EpiInProj {
    static constexpr bool PERM = true, AFTER_DRAIN = false;
    const float* ss; bf16_t *G, *Q, *K, *V; float* LF; const float *gq, *gk, *bfg; float c2;
    __device__ __forceinline__ void operator()(const f32x4 (&acc)[2][2][4][2], const Unit& u, int wr, int wc, int fr, int fq) const {
        const int p = u.pn; const int rowb = u.pm * BM + wr * 64 + fr;
        if (p < 4) {
#pragma unroll
            for (int ai = 0; ai < 2; ++ai)
#pragma unroll
                for (int m = 0; m < 4; ++m) { const int row = rowb + ai * HALF + m * 16; const float inv = row_inv(ss, row);
                    f32x4 o[2];
#pragma unroll
                    for (int n = 0; n < 2; ++n) { const f32x4 v = acc[ai][0][m][n] * inv, g = acc[ai][1][m][n] * inv;
#pragma unroll
                        for (int e = 0; e < 4; ++e) o[n][e] = v[e] * sigm(g[e]); }
                    *(u32x4*)(G + (size_t)row * 512 + p * 128 + wc * 32 + fq * 8) = pack8(o[0], o[1]); }
        } else if (p < 8) {
            const bool isq = p < 6; const float* gp = isq ? gq : gk; bf16_t* O = isq ? Q : K; const float sc = isq ? c2 : 1.0f; const int hh = 4 * (p & 1) + wc;
            f32x4 gv[2][2];
#pragma unroll
            for (int bj = 0; bj < 2; ++bj)
#pragma unroll
                for (int n = 0; n < 2; ++n) gv[bj][n] = *(const f32x4*)(gp + 32 * bj + 8 * fq + 4 * n) * sc;
#pragma unroll
            for (int ai = 0; ai < 2; ++ai)
#pragma unroll
                for (int m = 0; m < 4; ++m) { const int row = rowb + ai * HALF + m * 16; const float inv = row_inv(ss, row);
                    f32x4 a[2][2]; float s = 0.f;
#pragma unroll
                    for (int bj = 0; bj < 2; ++bj)
#pragma unroll
                        for (int n = 0; n < 2; ++n) { a[bj][n] = acc[ai][bj][m][n] * inv; s += (a[bj][n][0] * a[bj][n][0] + a[bj][n][1] * a[bj][n][1]) + (a[bj][n][2] * a[bj][n][2] + a[bj][n][3] * a[bj][n][3]); }
                    s += __shfl_xor(s, 16); s += __shfl_xor(s, 32);
                    const float rinv = __builtin_amdgcn_rsqf(s * (1.0f / 64.0f) + 1e-6f);
#pragma unroll
                    for (int bj = 0; bj < 2; ++bj)
                        *(u32x4*)(O + (size_t)row * 512 + hh * 64 + 32 * bj + 8 * fq) = pack8(a[bj][0] * rinv * gv[bj][0], a[bj][1] * rinv * gv[bj][1]); }
        } else if (p < 10) {
#pragma unroll
            for (int ai = 0; ai < 2; ++ai)
#pragma unroll
                for (int m = 0; m < 4; ++m) { const int row = rowb + ai * HALF + m * 16; const float inv = row_inv(ss, row);
#pragma unroll
                    for (int bj = 0; bj < 2; ++bj)
                        *(u32x4*)(V + (size_t)row * 512 + (p - 8) * 256 + bj * HALF + wc * 32 + fq * 8) = pack8(acc[ai][bj][m][0] * inv, acc[ai][bj][m][1] * inv); }
        } else {
            if (wc == 0 && fq == 0) {
#pragma unroll
                for (int ai = 0; ai < 2; ++ai)
#pragma unroll
                    for (int m = 0; m < 4; ++m) { const int row = rowb + ai * HALF + m * 16; const float inv = row_inv(ss, row); const int b = row >> 13, t = row & 8191;
#pragma unroll
                        for (int n = 0; n < 2; ++n)
#pragma unroll
                            for (int e = 0; e < 4; ++e) { const int h = 4 * n + e; const float z = acc[ai][0][m][n][e] * inv + bfg[h];
                                const float lf = fminf(z, 0.f) - __logf(1.0f + __expf(-fabsf(z)));
                                LF[(size_t)(b * 8 + h) * 8192 + t] = lf; } }
            }
        }
    }
};
struct EpiGatePair {
    static constexpr bool PERM = true, AFTER_DRAIN = false;
    bf16_t *GA, *GB; int apm_off;
    __device__ __forceinline__ void operator()(const f32x4 (&acc)[2][2][4][2], const Unit& u, int wr, int wc, int fr, int fq) const {
        const bool second = u.pn >= 4; const int pm = second ? u.pm + apm_off : u.pm, pn = second ? u.pn - 4 : u.pn;
        bf16_t* IO = second ? GB : GA;
        const int rowb = pm * BM + wr * 64 + fr, colb = pn * BM + wc * 32 + fq * 8;
#pragma unroll
        for (int ai = 0; ai < 2; ++ai)
#pragma unroll
            for (int m = 0; m < 4; ++m) { const int row = rowb + ai * HALF + m * 16;
#pragma unroll
                for (int bj = 0; bj < 2; ++bj) { const size_t off = (size_t)row * 1024 + colb + bj * HALF;
                    f32x4 g0, g1; unpack8(*(const u32x4*)(IO + off), g0, g1);
                    f32x4 o0 = g0 * acc[ai][bj][m][0], o1 = g1 * acc[ai][bj][m][1];
                    if (second) { f32x4 y0, y1; unpack8(*(const u32x4*)(GA + off), y0, y1); o0 += y0; o1 += y1; }
                    *(u32x4*)(IO + off) = pack8(o0, o1); } }
    }
};
struct PairOrder { StaticOrder s; int apm_off;
    __device__ __forceinline__ bool next(int i, Unit& u) const { if (i >= 2) return false; if (!s.next(0, u)) return false; if (i == 1) { u.pm -= apm_off; u.pn += 4; } return true; }
    __device__ __forceinline__ void a_ready(const Unit&) const {}
    __device__ __forceinline__ void done(const Unit&) const {} };
template <bool FINAL> struct EpiResid {
    static constexpr bool PERM = true, AFTER_DRAIN = false;
    float* Xout; bf16_t* XB; float* SS; bf16_t* XBo; float* SSo;
    __device__ __forceinline__ void operator()(const f32x4 (&acc)[2][2][4][2], const Unit& u, int wr, int wc, int fr, int fq) const {
        const int rowb = u.pm * BM + wr * 64 + fr, colb = u.pn * BM + wc * 32 + fq * 8;
#pragma unroll
        for (int ai = 0; ai < 2; ++ai)
#pragma unroll
            for (int m = 0; m < 4; ++m) { const int row = rowb + ai * HALF + m * 16; float s = 0.f;
#pragma unroll
                for (int bj = 0; bj < 2; ++bj) { const size_t off = (size_t)row * 1024 + colb + bj * HALF;
                    f32x4 x0, x1; unpack8(*(const u32x4*)(XB + off), x0, x1); x0 += acc[ai][bj][m][0]; x1 += acc[ai][bj][m][1];
                    if (FINAL) { *(f32x4*)(Xout + off) = x0; *(f32x4*)(Xout + off + 4) = x1; }
                    else { const u32x4 w = pack8(x0, x1); *(u32x4*)(XBo + off) = w; unpack8(w, x0, x1);
                        s += ((x0[0] * x0[0] + x0[1] * x0[1]) + (x0[2] * x0[2] + x0[3] * x0[3])) + ((x1[0] * x1[0] + x1[1] * x1[1]) + (x1[2] * x1[2] + x1[3] * x1[3])); } }
                if (!FINAL) { s += __shfl_xor(s, 16); s += __shfl_xor(s, 32);
                    if (fq == 0) SSo[(size_t)row * 16 + u.pn * 4 + wc] = s; } }
    }
};
struct EpiSwiglu {
    static constexpr bool PERM = true, AFTER_DRAIN = false;
    const float* ss; bf16_t* HB;
    __device__ __forceinline__ void operator()(const f32x4 (&acc)[2][2][4][2], const Unit& u, int wr, int wc, int fr, int fq) const {
        const int rowb = u.pm * BM + wr * 64 + fr;
#pragma unroll
        for (int ai = 0; ai < 2; ++ai)
#pragma unroll
            for (int m = 0; m < 4; ++m) { const int row = rowb + ai * HALF + m * 16; const float inv = row_inv(ss, row);
                f32x4 o[2];
#pragma unroll
                for (int n = 0; n < 2; ++n) { const f32x4 g = acc[ai][0][m][n] * inv, v = acc[ai][1][m][n] * inv;
#pragma unroll
                    for (int e = 0; e < 4; ++e) o[n][e] = g[e] * sigm(g[e]) * v[e]; }
                *(u32x4*)(HB + (size_t)row * 2816 + u.pn * 128 + wc * 32 + fq * 8) = pack8(o[0], o[1]); }
    }
};

template <class Epi, class Sched, bool ALIGN_EPI = false, bool SP2 = false>
__device__ __forceinline__ void gemm_phase(PG8_LAS unsigned char* lds, const Gemm g, const Sched& S, const Epi& E) {
    int tid = threadIdx.x; asm volatile("" : "+v"(tid));
    const int wid = __builtin_amdgcn_readfirstlane(tid >> 6), lane = tid & 63, wr = wid >> 2, wc = wid & 3, fr = lane & 15, fq = lane >> 4;
    const int K = g.K, nt = K / BK;
    unsigned voffA[2], voffB[2];
#pragma unroll
    for (int i = 0; i < 2; ++i) { int R, C; stage_rc(tid * 16 + i * 8192, R, C); const int Rb = Epi::PERM ? ((R & ~31) + perm32(R & 31)) : R;
        voffA[i] = (unsigned)(R * K + C) * 2u; voffB[i] = (unsigned)(Rb * K + C) * 2u; }
    const size_t kstep = (size_t)(BK * 2);
    const size_t hstep = (size_t)HALF * K * 2;
    const size_t tstep = 2 * hstep;
    const unsigned ldsw = (unsigned)wid * 1024u;
    const int aoff = lds_byte(wr * 64 + fr, fq * 8), boff = lds_byte(wc * 32 + fr, fq * 8);
#define PG8_SA(b, h) (((b) * 2 + (h)) * HTB)
#define PG8_SB(b, h) ((4 + (b) * 2 + (h)) * HTB)
#define PG8_STAGE(bufoff, gbase, voff) do { _Pragma("unroll") for (int _i = 0; _i < 2; ++_i) \
        __builtin_amdgcn_global_load_lds((const unsigned*)((const char*)(gbase) + (voff)[_i]), (PG8_LAS unsigned*)(lds + (bufoff) + ldsw + _i * 8192), 16, 0, 0); } while (0)
#define PG8_LDA(dst, b, h) do { _Pragma("unroll") for (int m = 0; m < 4; ++m) _Pragma("unroll") for (int k = 0; k < 2; ++k) dst[m][k] = *(const PG8_LAS bf16x8*)(lds + PG8_SA(b, h) + aoff + m * 2048 + k * 1024); } while (0)
#define PG8_LDB(dst, b, h) do { _Pragma("unroll") for (int n = 0; n < 2; ++n) _Pragma("unroll") for (int k = 0; k < 2; ++k) dst[n][k] = *(const PG8_LAS bf16x8*)(lds + PG8_SB(b, h) + boff + n * 2048 + k * 1024); } while (0)
#define PG8_MMA(ai, bj, At, Bt) do { __builtin_amdgcn_s_setprio(1); _Pragma("unroll") for (int m = 0; m < 4; ++m) _Pragma("unroll") for (int n = 0; n < 2; ++n) _Pragma("unroll") for (int k = 0; k < 2; ++k) \
        acc[ai][bj][m][n] = __builtin_amdgcn_mfma_f32_16x16x32_bf16(Bt[n][k], At[m][k], acc[ai][bj][m][n], 0, 0, 0); __builtin_amdgcn_s_setprio(0); } while (0)
#define PG8_WAIT_V(n) asm volatile("s_waitcnt vmcnt(" #n ")" ::: "memory")
#define PG8_WAIT_L(n) asm volatile("s_waitcnt lgkmcnt(" #n ")" ::: "memory")
#define PG8_BAR __builtin_amdgcn_s_barrier()
#define PG8_SCHED __builtin_amdgcn_sched_barrier(0)
    Unit cur, nxt; int ui = 0;
    if (!S.next(0, cur)) return;
    f32x4 acc[2][2][4][2];
#pragma unroll
    for (int a = 0; a < 2; ++a)
#pragma unroll
        for (int b = 0; b < 2; ++b)
#pragma unroll
            for (int m = 0; m < 4; ++m)
#pragma unroll
                for (int n = 0; n < 2; ++n) acc[a][b][m][n] = (f32x4){0.f, 0.f, 0.f, 0.f};
    bf16x8 At[4][2], B0[2][2], B1[2][2];
    const char* cA = (const char*)g.A + (size_t)cur.pm * tstep; const char* cB = (const char*)g.Bt + (size_t)cur.pn * tstep;
    S.a_ready(cur);
    if constexpr (SP2) {
        PG8_STAGE(PG8_SB(0, 0), cB, voffB); PG8_STAGE(PG8_SB(0, 1), cB + hstep, voffB); PG8_STAGE(PG8_SA(0, 0), cA, voffA); PG8_STAGE(PG8_SA(0, 1), cA + hstep, voffA);
        if (wr == 1) PG8_BAR;
        PG8_WAIT_V(2); PG8_BAR;
        PG8_STAGE(PG8_SB(1, 0), cB + kstep, voffB); PG8_STAGE(PG8_SA(1, 0), cA + kstep, voffA); PG8_STAGE(PG8_SB(1, 1), cB + hstep + kstep, voffB);
        PG8_WAIT_V(6); PG8_BAR;
    } else {
        PG8_STAGE(PG8_SB(0, 0), cB, voffB); PG8_STAGE(PG8_SA(0, 0), cA, voffA); PG8_STAGE(PG8_SB(0, 1), cB + hstep, voffB); PG8_STAGE(PG8_SA(0, 1), cA + hstep, voffA);
        if (wr == 1) PG8_BAR;
        PG8_WAIT_V(4); PG8_BAR;
        PG8_STAGE(PG8_SB(1, 0), cB + kstep, voffB); PG8_STAGE(PG8_SA(1, 0), cA + kstep, voffA); PG8_STAGE(PG8_SB(1, 1), cB + hstep + kstep, voffB);
        PG8_WAIT_V(6); PG8_BAR;
    }
    for (;;) {
        const bool has_next = S.next(ui + 1, nxt);
        const char* nA = has_next ? (const char*)g.A + (size_t)nxt.pm * tstep : cA; const char* nB = has_next ? (const char*)g.Bt + (size_t)nxt.pn * tstep : cB;
        for (int t = 0; t < nt; t += 2) {
            const bool last = (t == nt - 2);
            const char* a1 = cA + (size_t)(t + 1) * kstep;
            const char* a2 = last ? nA : cA + (size_t)(t + 2) * kstep; const char* b2 = last ? nB : cB + (size_t)(t + 2) * kstep;
            const char* a3 = a2 + kstep; const char* b3 = b2 + kstep;
            if (last && has_next) S.a_ready(nxt);
            if constexpr (SP2) {
            PG8_LDB(B0, 0, 0); PG8_LDB(B1, 0, 1); PG8_SCHED; PG8_LDA(At, 0, 0); PG8_STAGE(PG8_SA(1, 1), a1 + hstep, voffA);
            PG8_WAIT_V(8); PG8_WAIT_L(0); PG8_BAR; PG8_MMA(0, 0, At, B0); PG8_MMA(0, 1, At, B1); PG8_BAR; PG8_SCHED;
            PG8_LDA(At, 0, 1); PG8_STAGE(PG8_SB(0, 0), b2, voffB); PG8_STAGE(PG8_SB(0, 1), b2 + hstep, voffB); PG8_STAGE(PG8_SA(0, 0), a2, voffA);
            PG8_WAIT_V(8); PG8_WAIT_L(0); PG8_BAR; PG8_MMA(1, 0, At, B0); PG8_MMA(1, 1, At, B1); PG8_BAR; PG8_SCHED;
            PG8_LDB(B0, 1, 0); PG8_LDB(B1, 1, 1); PG8_SCHED; PG8_LDA(At, 1, 0); PG8_STAGE(PG8_SA(0, 1), a2 + hstep, voffA);
            PG8_WAIT_V(8); PG8_WAIT_L(0); PG8_BAR; PG8_MMA(0, 0, At, B0); PG8_MMA(0, 1, At, B1); PG8_BAR; PG8_SCHED;
            PG8_LDA(At, 1, 1); PG8_STAGE(PG8_SB(1, 0), b3, voffB); PG8_STAGE(PG8_SB(1, 1), b3 + hstep, voffB); PG8_STAGE(PG8_SA(1, 0), a3, voffA);
            PG8_WAIT_V(8); PG8_WAIT_L(0); PG8_BAR; PG8_MMA(1, 0, At, B0); PG8_MMA(1, 1, At, B1); PG8_BAR; PG8_SCHED;
            } else {
            PG8_LDB(B0, 0, 0); PG8_SCHED; PG8_LDA(At, 0, 0); PG8_STAGE(PG8_SA(1, 1), a1 + hstep, voffA);
            PG8_WAIT_L(8); PG8_BAR; PG8_WAIT_L(0); PG8_MMA(0, 0, At, B0); PG8_BAR; PG8_SCHED;
            PG8_LDB(B1, 0, 1); PG8_STAGE(PG8_SB(0, 0), b2, voffB);
            PG8_BAR; PG8_WAIT_L(0); PG8_MMA(0, 1, At, B1); PG8_BAR;
            PG8_LDA(At, 0, 1); PG8_STAGE(PG8_SA(0, 0), a2, voffA);
            PG8_BAR; PG8_WAIT_L(0); PG8_MMA(1, 0, At, B0); PG8_BAR; PG8_SCHED;
            PG8_STAGE(PG8_SB(0, 1), b2 + hstep, voffB);
            PG8_WAIT_V(6); PG8_BAR; PG8_MMA(1, 1, At, B1); PG8_BAR;
            PG8_LDB(B0, 1, 0); PG8_SCHED; PG8_LDA(At, 1, 0); PG8_STAGE(PG8_SA(0, 1), a2 + hstep, voffA);
            PG8_WAIT_L(8); PG8_BAR; PG8_WAIT_L(0); PG8_MMA(0, 0, At, B0); PG8_BAR; PG8_SCHED;
            PG8_LDB(B1, 1, 1); PG8_STAGE(PG8_SB(1, 0), b3, voffB);
            PG8_BAR; PG8_WAIT_L(0); PG8_MMA(0, 1, At, B1); PG8_BAR;
            PG8_LDA(At, 1, 1); PG8_STAGE(PG8_SA(1, 0), a3, voffA);
            PG8_BAR; PG8_WAIT_L(0); PG8_MMA(1, 0, At, B0); PG8_BAR; PG8_SCHED;
            PG8_STAGE(PG8_SB(1, 1), b3 + hstep, voffB);
            PG8_WAIT_V(6); PG8_BAR; PG8_MMA(1, 1, At, B1); PG8_BAR;
            }
        }
        if constexpr (ALIGN_EPI) { if (wr == 0) PG8_BAR; }
        if constexpr (!Epi::AFTER_DRAIN) { E(acc, cur, wr, wc, fr, fq); S.done(cur); }
        if (!has_next) break;
#pragma unroll
        for (int a = 0; a < 2; ++a)
#pragma unroll
            for (int b = 0; b < 2; ++b)
#pragma unroll
                for (int m = 0; m < 4; ++m)
#pragma unroll
                    for (int n = 0; n < 2; ++n) acc[a][b][m][n] = (f32x4){0.f, 0.f, 0.f, 0.f};
        cur = nxt; cA = nA; cB = nB; ++ui;
        if constexpr (ALIGN_EPI) { if (wr == 1) PG8_BAR; }
    }
    PG8_WAIT_V(0);
    if constexpr (!ALIGN_EPI) { if (wr == 0) PG8_BAR; }
    PG8_BAR;
    if constexpr (Epi::AFTER_DRAIN) { E.fused(acc, cur, wr, wc, fr, fq, lds, wid, lane); S.done(cur); }
#undef PG8_SA
#undef PG8_SB
#undef PG8_STAGE
#undef PG8_LDA
#undef PG8_LDB
#undef PG8_MMA
#undef PG8_WAIT_V
#undef PG8_WAIT_L
#undef PG8_BAR
#undef PG8_SCHED
}
}

#ifndef PG8_SP2
#define PG8_SP2 true
#endif
#ifndef PG8_ALIGN
#define PG8_ALIGN true
#endif
#include <hip/hip_bf16.h>
#include <cmath>
namespace attn_body {
using bf16=__hip_bfloat16;
using bf16x8=__attribute__((ext_vector_type(8)))short;
using s16x4=__attribute__((ext_vector_type(4)))short;
using f32x16=__attribute__((ext_vector_type(16)))float;
using u32x4=__attribute__((ext_vector_type(4)))unsigned;
constexpr int BATCH=2,NHEAD=8,SEQ=8192,D=64,DM=NHEAD*D;
constexpr int NW=8,QBLK=32,QB=QBLK*NW,KVBLK=64,NQB=SEQ/QB;
constexpr int ATTN_PITCH=DM, ATTN_UNIT_ROWS=QB;
__device__ __forceinline__ int crow(int r,int hi){return (r&3)+8*(r>>2)+4*hi;}
#define SBAR() __builtin_amdgcn_sched_barrier(0)
__device__ __forceinline__ void cmask(f32x16&p0,f32x16&p1,int jb,int qrel,int hi){
  const float NEG=-INFINITY; int kb=64*jb+4*hi;
  #pragma unroll
  for(int r=0;r<16;++r){int kv=kb+(r&3)+8*(r>>2); if(kv>qrel)p0[r]=NEG; if(kv+32>qrel)p1[r]=NEG;}
}

constexpr int NSLOT=3, SLOTB=8192;
constexpr int LDS_K=0, LDS_V=NSLOT*SLOTB, LDS_WS=2*NSLOT*SLOTB, LDS_OST=LDS_WS+NW*64*4, LDS_CL=86016, LDS_BYTES=LDS_CL+SEQ*4;
constexpr float C2=0.125f*1.4426950408889634f;
__device__ __forceinline__ void glds16(const void*gsrc,unsigned lds_dst){unsigned keep;
  asm volatile("s_mov_b32 %0, m0\n\ts_mov_b32 m0, %2\n\ts_nop 0\n\tglobal_load_lds_dwordx4 %1, off\n\ts_mov_b32 m0, %0":"=&s"(keep):"v"(gsrc),"s"(lds_dst):"memory");}
__device__ __forceinline__ float max3f(float a,float b,float c){float r;asm("v_max3_f32 %0, %1, %2, %3":"=v"(r):"v"(a),"v"(b),"v"(c));return r;}
__device__ __forceinline__ float max2f(float a,float b){float r;asm("v_max_f32_e32 %0, %1, %2":"=v"(r):"v"(a),"v"(b));return r;}
__device__ __forceinline__ float fadd_s(float a,float b){float r;asm("v_add_f32_e32 %0, %1, %2":"=v"(r):"v"(a),"v"(b));return r;}
__device__ __forceinline__ float fsub_s(float a,float b){float r;asm("v_sub_f32_e32 %0, %1, %2":"=v"(r):"v"(a),"v"(b));return r;}
typedef float f32x2_t __attribute__((ext_vector_type(2))); typedef __bf16 bf16x2_t __attribute__((ext_vector_type(2)));
__device__ __forceinline__ unsigned cvtpk_s(float lo,float hi){f32x2_t v={lo,hi};bf16x2_t b=__builtin_convertvector(v,bf16x2_t);return __builtin_bit_cast(unsigned,b);}
#define WAIT_BAR(N) asm volatile("s_waitcnt vmcnt(" #N ") lgkmcnt(0)\n\ts_barrier":::"memory")

__device__ __forceinline__ void qkt(f32x16&p0,f32x16&p1,const char*Kslot,const bf16x8*qr,int r32,int hi){
  const char*kb=Kslot+hi*1024+r32*16;
  #pragma unroll
  for(int d0=0;d0<4;++d0){
    const bf16x8 b0=*reinterpret_cast<const bf16x8*>(kb+d0*2048);
    const bf16x8 b1=*reinterpret_cast<const bf16x8*>(kb+d0*2048+512);
    p0=__builtin_amdgcn_mfma_f32_32x32x16_bf16(b0,qr[d0],p0,0,0,0);p1=__builtin_amdgcn_mfma_f32_32x32x16_bf16(b1,qr[d0],p1,0,0,0);}
}
typedef __attribute__((address_space(3))) const char* lds_cptr;
typedef short v4i16_t __attribute__((ext_vector_type(4)));
__device__ __forceinline__ void kload8(bf16x8*kf,lds_cptr kp){
  kf[0]=*(const __attribute__((address_space(3))) bf16x8*)(kp);      kf[1]=*(const __attribute__((address_space(3))) bf16x8*)(kp+512);
  kf[2]=*(const __attribute__((address_space(3))) bf16x8*)(kp+2048); kf[3]=*(const __attribute__((address_space(3))) bf16x8*)(kp+2560);
  kf[4]=*(const __attribute__((address_space(3))) bf16x8*)(kp+4096); kf[5]=*(const __attribute__((address_space(3))) bf16x8*)(kp+4608);
  kf[6]=*(const __attribute__((address_space(3))) bf16x8*)(kp+6144); kf[7]=*(const __attribute__((address_space(3))) bf16x8*)(kp+6656);
}
__device__ __forceinline__ void kload2(bf16x8*kf,lds_cptr kp,int j){ kf[2*j]=*(const __attribute__((address_space(3))) bf16x8*)(kp+j*2048); kf[2*j+1]=*(const __attribute__((address_space(3))) bf16x8*)(kp+j*2048+512); }
__device__ __forceinline__ s16x4 vtr(lds_cptr p){ return __builtin_bit_cast(s16x4,__builtin_amdgcn_ds_read_tr16_b64_v4i16((__attribute__((address_space(3))) v4i16_t*)p)); }
__device__ __forceinline__ float rowmax(const f32x16&p0,const f32x16&p1){
  float a=max3f(p0[0],p0[1],p1[0]),b=max3f(p0[2],p0[3],p1[1]);a=max3f(a,p1[2],p1[3]);
  #pragma unroll
  for(int r=4;r<16;r+=4){a=max3f(a,p0[r],p0[r+1]);b=max3f(b,p0[r+2],p0[r+3]);a=max3f(a,p1[r],p1[r+1]);b=max3f(b,p1[r+2],p1[r+3]);}
  const float m=max2f(a,b);
  auto rr=__builtin_amdgcn_permlane32_swap(__float_as_uint(m),__float_as_uint(m),false,false);
  return max2f(__uint_as_float(rr[0]),__uint_as_float(rr[1]));
}
__device__ __forceinline__ void pv(f32x16*o,int vb,bf16x8 pa0,bf16x8 pa1,bf16x8 pa2,bf16x8 pa3){
  #pragma unroll
  for(int d0=0;d0<2;++d0){s16x4 lo[4],hi[4];
    #pragma unroll
    for(int ks=0;ks<4;++ks){
      asm volatile("ds_read_b64_tr_b16 %0,%1 offset:%c2":"=&v"(lo[ks]):"v"(vb),"i"(d0*4096+ks*1024):"memory");
      asm volatile("ds_read_b64_tr_b16 %0,%1 offset:%c2":"=&v"(hi[ks]):"v"(vb),"i"(d0*4096+ks*1024+512):"memory");}
    asm volatile("s_waitcnt lgkmcnt(0)":::"memory");SBAR();
    #define PK(k) (bf16x8){lo[k][0],lo[k][1],lo[k][2],lo[k][3],hi[k][0],hi[k][1],hi[k][2],hi[k][3]}
    o[d0]=__builtin_amdgcn_mfma_f32_32x32x16_bf16(pa0,PK(0),o[d0],0,0,0);
    o[d0]=__builtin_amdgcn_mfma_f32_32x32x16_bf16(pa1,PK(1),o[d0],0,0,0);
    o[d0]=__builtin_amdgcn_mfma_f32_32x32x16_bf16(pa2,PK(2),o[d0],0,0,0);
    o[d0]=__builtin_amdgcn_mfma_f32_32x32x16_bf16(pa3,PK(3),o[d0],0,0,0);
    #undef PK
  }
}

#ifndef ATTN_STORE16
#define ATTN_STORE16(p,v) (*(u32x4*)(p)=(v))
#endif
template<int THRL> __device__ __forceinline__ void attn_unit(int b,int h,int qb,const bf16*Q,const bf16*__restrict__ K,const bf16*__restrict__ V,bf16*O,const float*__restrict__ CLg,const float*__restrict__ GQg,const float*__restrict__ GKg,char*shm){
  int tid=threadIdx.x; asm volatile("":"+v"(tid)); const int lane=tid&63,r32=lane&31,hi=lane>>5; const int wid=__builtin_amdgcn_readfirstlane(tid>>6);
  const long rowbase=(long)b*SEQ; const int q0=qb*QB;
  const bf16*Qw=Q+(rowbase+q0+wid*QBLK)*DM+h*D;
  const lds_cptr shm3=(lds_cptr)shm;
  const unsigned lds0=(unsigned)(uintptr_t)shm;
  float*wsf=(float*)(shm+LDS_WS)+wid*64;
  typedef __attribute__((address_space(3))) float lds_f32; typedef float f32x4_t __attribute__((ext_vector_type(4)));
  lds_f32* const cl3=(lds_f32*)(shm3+LDS_CL);
  bf16x8 qr[4];
  #pragma unroll
  for(int d0=0;d0<4;++d0)qr[d0]=*reinterpret_cast<const bf16x8*>(&Qw[(long)r32*DM+d0*16+hi*8]);
  const float mq0_=GQg[lane],mk0_=GKg[lane];
  { const float*cg=CLg+((long)(b*NHEAD+h))*SEQ;
    const int n_=q0+QB; f32x4_t v_[4]; float run_=0.f;
    if(tid*16<n_){
      #pragma unroll
      for(int j_=0;j_<4;++j_)v_[j_]=*(const f32x4_t*)(cg+tid*16+4*j_);
      #pragma unroll
      for(int j_=0;j_<4;++j_){
        #pragma unroll
        for(int e_=0;e_<4;++e_){run_+=v_[j_][e_];v_[j_][e_]=run_;} } }
    float inc_=run_;
    #pragma unroll
    for(int o_=1;o_<64;o_<<=1){ const float y_=__shfl_up(inc_,o_); if(lane>=o_)inc_+=y_; }
    lds_f32* const wt_=(lds_f32*)(shm3+LDS_WS);
    if(lane==63)wt_[wid]=inc_;
    asm volatile("s_waitcnt vmcnt(0) lgkmcnt(0)\n\ts_barrier":::"memory");
    float off_=inc_-run_;
    for(int w_=0;w_<wid;++w_)off_+=wt_[w_];
    if(tid*16<n_){
      #pragma unroll
      for(int j_=0;j_<4;++j_)*(__attribute__((address_space(3))) f32x4_t*)(cl3+tid*16+4*j_)=(v_[j_]+off_)*1.4426950408889634f; }
    asm volatile("s_waitcnt vmcnt(0) lgkmcnt(0)\n\ts_barrier":::"memory"); }
  int t_start=0; bool chk_=true;
  { float mq=fabsf(mq0_),mk=fabsf(mk0_);
    #pragma unroll
    for(int o_=1;o_<64;o_<<=1){ mq=fmaxf(mq,__shfl_xor(mq,o_)); mk=fmaxf(mk,__shfl_xor(mk,o_)); }
    const float thr=-(40.0f+2.0f*8.0f*1.4426950408889634f*mq*mk), cq0=cl3[q0]; const int kmax=(q0+QB)/KVBLK/2-2; int kk=0;
    #pragma unroll
    for(int st_=32;st_>=1;st_>>=1){ const int c_=kk+st_; if(c_<=kmax){ if(cq0-cl3[128*c_-1]<thr)kk=c_; } }
    t_start=__builtin_amdgcn_readfirstlane(2*kk);
    chk_=__builtin_amdgcn_readfirstlane((int)!(8.0f*1.4426950408889634f*mq*mk*1.01f<(float)THRL-0.5f))!=0; }
  const int NT=(q0+QB)/KVBLK-t_start;
  lds_f32* const cl3t=cl3+t_start*KVBLK;
  const bf16*Kh=K+(rowbase+(long)t_start*KVBLK)*DM+h*D,*Vh=V+(rowbase+(long)t_start*KVBLK)*DM+h*D;
  const float cli=cl3[q0+wid*QBLK+r32];
  const bf16*ksrc=Kh+(long)lane*DM+wid*8;
  const bf16*vsrc=Vh+(long)(16*(wid&3)+(lane>>2))*DM+(wid>>2)*32+(lane&3)*8;
  const unsigned kdst=lds0+LDS_K+wid*1024, vdst=lds0+LDS_V+wid*1024;
  #define DMA_K(t,slot) glds16(ksrc+(long)(t)*KVBLK*DM,(unsigned)__builtin_amdgcn_readfirstlane(kdst+(slot)))
  #define DMA_V(t,slot) glds16(vsrc+(long)(t)*KVBLK*DM,(unsigned)__builtin_amdgcn_readfirstlane(vdst+(slot)))
  const int vb0=(int)(lds0+LDS_V)+((lane>>4)&1)*32+(lane&3)*8+(4*hi+((lane&15)>>2))*64;
  const char*Kbase=shm+LDS_K; bf16x8 kf[8];
  const lds_cptr kp0=shm3+LDS_K+hi*1024+r32*16; const lds_cptr vp0=shm3+LDS_V+((lane>>4)&1)*32+(lane&3)*8+(4*hi+((lane&15)>>2))*64;
  #define BIASFILL(X0,X1,t) do{ const lds_f32* cp_=cl3t+(t)*KVBLK+4*hi; const float bs_=cli-mhat; \
    _Pragma("unroll") for(int g_=0;g_<4;++g_){ const f32x4_t a_=*(const __attribute__((address_space(3))) f32x4_t*)(cp_+8*g_); const f32x4_t b_=*(const __attribute__((address_space(3))) f32x4_t*)(cp_+32+8*g_); \
      _Pragma("unroll") for(int e_=0;e_<4;++e_){ X0[4*g_+e_]=bs_-a_[e_]; X1[4*g_+e_]=bs_-b_[e_]; } } }while(0)
  DMA_K(0,0);DMA_V(0,0);DMA_K(1,SLOTB);
  float mhat=0.f,l_reg=0.f;f32x16 o[2];o[0]=f32x16{};o[1]=f32x16{};
  const int qrel=wid*QBLK+r32;
  #define CMASK(P0,P1,t) do{int jb_=(t)-(NT-4); if(jb_>=0)cmask(P0,P1,jb_,qrel,hi);}while(0)
  bool resc=false;
  #define START(P0,P1) do{ const float rm=rowmax(P0,P1); resc=false; \
    { const float dl=max2f(rm,0.f); mhat=fadd_s(mhat,dl); \
      _Pragma("unroll") for(int r=0;r<16;++r){P0[r]=fsub_s(P0[r],dl);P1[r]=fsub_s(P1[r],dl);} } \
    _Pragma("unroll") for(int r=0;r<16;++r)P0[r]=__builtin_amdgcn_exp2f(P0[r]); }while(0)
  #define RESC() do{ if(resc){ asm volatile("s_waitcnt lgkmcnt(0)":::"memory"); \
      _Pragma("unroll") for(int d_=0;d_<2;++d_) _Pragma("unroll") for(int r=0;r<16;++r)o[d_][r]*=wsf[crow(r,hi)]; } }while(0)
  f32x16 pA0,pA1,pB0,pB1;
  int sl_prev=0,sl_cur=0,sl_next=SLOTB;
  #define ROT() do{sl_prev=sl_cur;sl_cur=sl_next;sl_next=(sl_next==(NSLOT-1)*SLOTB)?0:sl_next+SLOTB;}while(0)
  DMA_K(2,2*SLOTB);
  WAIT_BAR(3);
  BIASFILL(pA0,pA1,0); qkt(pA0,pA1,Kbase,qr,r32,hi);asm volatile("s_nop 15\n\ts_nop 7":"+v"(pA0),"+v"(pA1));CMASK(pA0,pA1,0);
  START(pA0,pA1);
  _Pragma("unroll") for(int r=0;r<16;++r)pA1[r]=__builtin_amdgcn_exp2f(pA1[r]);
  BIASFILL(pB0,pB1,1);
  WAIT_BAR(0);
  DMA_K(3,0);DMA_V(1,SLOTB);
  ROT();
  kload8(kf,kp0+sl_cur);
  WAIT_BAR(2);
  s16x4 vlo[8],vhi[8]; u32x4 pw0,pw1,pw2,pw3;
  #define PKW(P,B) cvtpk_s(P[B],P[B+1])
  #define PAF(k) __builtin_bit_cast(bf16x8,pw##k)
  #define VFR(i) (bf16x8){vlo[i][0],vlo[i][1],vlo[i][2],vlo[i][3],vhi[i][0],vhi[i][1],vhi[i][2],vhi[i][3]}
  #define PIN(x) asm volatile("":"+v"(x))
  #define MX3(a,b,c) __builtin_fmaxf(__builtin_fmaxf((a),(b)),(c))
  #define GAPA(MF,A0,A1,A2,A3,W0,W1,PW) do{ MF; sacc+=A0; sacc+=A1; sacc+=A2; sacc+=A3; PIN(sacc); W0; W1; PIN(PW); SBAR(); }while(0)
  #define EX(v) __builtin_amdgcn_exp2f(v)
  #define GAPB(MF,X,B,GF_,Y,OFF) do{ MF; f32x4_t bl_; if(GF_){ bl_=*(const __attribute__((address_space(3))) f32x4_t*)(bcp_+(OFF)); } \
    X[B]=EX(X[B]); X[B+1]=EX(X[B+1]); X[B+2]=EX(X[B+2]); X[B+3]=EX(X[B+3]); PIN(X); \
    if(GF_){ Y[B]=bbs_-bl_[0]; Y[B+1]=bbs_-bl_[1]; Y[B+2]=bbs_-bl_[2]; Y[B+3]=bbs_-bl_[3]; PIN(Y); } SBAR(); }while(0)
  #define VRD(i) do{ vlo[i]=vtr(vp_+(((i)>>2)*4096+((i)&3)*1024)); vhi[i]=vtr(vp_+(((i)>>2)*4096+((i)&3)*1024+512)); }while(0)
  #define KRD(G,j) do{ if(G){ kload2(kf,kp0+sl_next,j); SBAR(); } }while(0)
  #define STEP(C0,C1,P0,P1,t,GK,GV,GL,GF) do{ SBAR(); \
    const lds_cptr vp_=vp0+sl_prev; \
    VRD(0); SBAR(); float sacc=(P0[0]+P0[1]); \
    GAPA(C0=__builtin_amdgcn_mfma_f32_32x32x16_bf16(kf[0],qr[0],C0,0,0,0), P0[2],P0[3],P0[4],P0[5],     pw0[0]=PKW(P0,0), pw0[1]=PKW(P0,2), pw0); \
    VRD(4); SBAR(); GAPA(C1=__builtin_amdgcn_mfma_f32_32x32x16_bf16(kf[1],qr[0],C1,0,0,0), P0[6],P0[7],P0[8],P0[9],     pw0[2]=PKW(P0,4), pw0[3]=PKW(P0,6), pw0); \
    VRD(1); SBAR(); GAPA(C0=__builtin_amdgcn_mfma_f32_32x32x16_bf16(kf[2],qr[1],C0,0,0,0),   P0[10],P0[11],P0[12],P0[13], pw1[0]=PKW(P0,8), pw1[1]=PKW(P0,10), pw1); \
    VRD(5); SBAR(); GAPA(C1=__builtin_amdgcn_mfma_f32_32x32x16_bf16(kf[3],qr[1],C1,0,0,0),   P0[14],P0[15],P1[0],P1[1],   pw1[2]=PKW(P0,12),pw1[3]=PKW(P0,14), pw1); \
    VRD(2); SBAR(); GAPA(C0=__builtin_amdgcn_mfma_f32_32x32x16_bf16(kf[4],qr[2],C0,0,0,0),   P1[2],P1[3],P1[4],P1[5],     pw2[0]=PKW(P1,0), pw2[1]=PKW(P1,2), pw2); \
    VRD(6); SBAR(); GAPA(C1=__builtin_amdgcn_mfma_f32_32x32x16_bf16(kf[5],qr[2],C1,0,0,0),   P1[6],P1[7],P1[8],P1[9],     pw2[2]=PKW(P1,4), pw2[3]=PKW(P1,6), pw2); \
    VRD(3); SBAR(); GAPA(C0=__builtin_amdgcn_mfma_f32_32x32x16_bf16(kf[6],qr[3],C0,0,0,0),   P1[10],P1[11],P1[12],P1[13], pw3[0]=PKW(P1,8), pw3[1]=PKW(P1,10), pw3); \
    VRD(7); SBAR(); GAPA(C1=__builtin_amdgcn_mfma_f32_32x32x16_bf16(kf[7],qr[3],C1,0,0,0),   P1[14],P1[15],0.f,0.f,       pw3[2]=PKW(P1,12),pw3[3]=PKW(P1,14), pw3); \
    l_reg+=sacc; \
    if(GK){DMA_K((t)+3,sl_cur);} if(GV){DMA_V((t)+1,sl_next);} \
    CMASK(C0,C1,t); \
    resc=false; \
    if(chk_){ float a=MX3(C0[0],C0[1],C1[0]),b=MX3(C0[2],C0[3],C1[1]); a=MX3(a,C1[2],C1[3]); \
      _Pragma("unroll") for(int r=4;r<16;r+=4){a=MX3(a,C0[r],C0[r+1]);b=MX3(b,C0[r+2],C0[r+3]);a=MX3(a,C1[r],C1[r+1]);b=MX3(b,C1[r+2],C1[r+3]);} \
      float rm=__builtin_fmaxf(a,b); { auto rr=__builtin_amdgcn_permlane32_swap(__float_as_uint(rm),__float_as_uint(rm),false,false); rm=__builtin_fmaxf(__uint_as_float(rr[0]),__uint_as_float(rr[1])); } \
      if(__builtin_expect(__any(rm>(float)THRL),0)){ const float dl=__builtin_fmaxf(rm,0.f); mhat+=dl; \
        _Pragma("unroll") for(int r=0;r<16;++r){C0[r]-=dl;C1[r]-=dl;} \
        const float f=__builtin_amdgcn_exp2f(-dl); l_reg*=f; if(hi==0)wsf[r32]=f; resc=true; } } \
    const lds_f32* const bcp_=cl3t+((t)+1)*KVBLK+4*hi; const float bbs_=cli-mhat; \
    SBAR(); \
    GAPB(o[0]=__builtin_amdgcn_mfma_f32_32x32x16_bf16(PAF(0),VFR(0),o[0],0,0,0), C0,0, GF,P0,0); \
    GAPB(o[1]=__builtin_amdgcn_mfma_f32_32x32x16_bf16(PAF(0),VFR(4),o[1],0,0,0), C0,4, GF,P0,8); \
    KRD(GL,0); GAPB(o[0]=__builtin_amdgcn_mfma_f32_32x32x16_bf16(PAF(1),VFR(1),o[0],0,0,0), C0,8, GF,P0,16); \
    KRD(GL,1); GAPB(o[1]=__builtin_amdgcn_mfma_f32_32x32x16_bf16(PAF(1),VFR(5),o[1],0,0,0), C0,12, GF,P0,24); \
    KRD(GL,2); GAPB(o[0]=__builtin_amdgcn_mfma_f32_32x32x16_bf16(PAF(2),VFR(2),o[0],0,0,0), C1,0, GF,P1,32); \
    KRD(GL,3); GAPB(o[1]=__builtin_amdgcn_mfma_f32_32x32x16_bf16(PAF(2),VFR(6),o[1],0,0,0), C1,4, GF,P1,40); \
    GAPB(o[0]=__builtin_amdgcn_mfma_f32_32x32x16_bf16(PAF(3),VFR(3),o[0],0,0,0), C1,8, GF,P1,48); \
    GAPB(o[1]=__builtin_amdgcn_mfma_f32_32x32x16_bf16(PAF(3),VFR(7),o[1],0,0,0), C1,12, GF,P1,56); \
    }while(0)
  int t=1;
  #undef CMASK
  #define CMASK(P0,P1,t) do{}while(0)
  for(;t+5<NT;t+=2){
    STEP(pB0,pB1,pA0,pA1,t,true,true,true,true);     WAIT_BAR(2); RESC(); ROT();
    STEP(pA0,pA1,pB0,pB1,t+1,true,true,true,true);   WAIT_BAR(2); RESC(); ROT();
  }
  #undef CMASK
  #define CMASK(P0,P1,t) do{int jb_=(t)-(NT-4); if(jb_>=0)cmask(P0,P1,jb_,qrel,hi);}while(0)
  #define ENDW(tt) do{ if((tt)+3<NT){WAIT_BAR(2);} else if((tt)+2<NT){WAIT_BAR(1);} else {WAIT_BAR(0);} }while(0)
  for(;t+1<NT;t+=2){
    STEP(pB0,pB1,pA0,pA1,t,(t+3<NT),(t+1<NT),(t+1<NT),true);       ENDW(t);   RESC(); ROT();
    STEP(pA0,pA1,pB0,pB1,t+1,(t+4<NT),(t+2<NT),(t+2<NT),true);     ENDW(t+1); RESC(); ROT();
  }
  STEP(pB0,pB1,pA0,pA1,NT-1,false,false,false,false); RESC();
  { float sacc=pB0[0]+pB0[1]; _Pragma("unroll") for(int r=2;r<16;++r)sacc+=pB0[r]; _Pragma("unroll") for(int r=0;r<16;++r)sacc+=pB1[r]; l_reg+=sacc;
    pw0=(u32x4){PKW(pB0,0),PKW(pB0,2),PKW(pB0,4),PKW(pB0,6)};pw1=(u32x4){PKW(pB0,8),PKW(pB0,10),PKW(pB0,12),PKW(pB0,14)};pw2=(u32x4){PKW(pB1,0),PKW(pB1,2),PKW(pB1,4),PKW(pB1,6)};pw3=(u32x4){PKW(pB1,8),PKW(pB1,10),PKW(pB1,12),PKW(pB1,14)};
    SBAR(); pv(o,vb0+sl_cur,PAF(0),PAF(1),PAF(2),PAF(3)); }
  #undef PKW
  #undef PAF
  #undef VFR
  #undef PIN
  #undef MX3
  #undef GAPA
  #undef GAPB
  #undef EX
  #undef VRD
  #undef KRD
  #undef STEP
  #undef ENDW
  {auto rr=__builtin_amdgcn_permlane32_swap(__float_as_uint(l_reg),__float_as_uint(l_reg),false,false);l_reg=__uint_as_float(rr[0])+__uint_as_float(rr[1]);}
  if(hi==0)wsf[32+r32]=l_reg;asm volatile("s_waitcnt lgkmcnt(0)":::"memory");
  float rli[16];
  #pragma unroll
  for(int r=0;r<16;++r)rli[r]=__builtin_amdgcn_rcpf(wsf[32+crow(r,hi)]);
  bf16*Ow=O+(rowbase+q0+wid*QBLK)*DM+h*D;
  { bf16*stg=(bf16*)(shm+LDS_OST)+wid*2048;
    #pragma unroll
    for(int r=0;r<16;++r){const int orow=crow(r,hi);
      #pragma unroll
      for(int d0=0;d0<2;++d0)stg[orow*64+d0*32+r32]=__float2bfloat16(o[d0][r]*rli[r]);}
    asm volatile("s_waitcnt lgkmcnt(0)":::"memory");
    #pragma unroll
    for(int i=0;i<4;++i){const int row=i*8+(lane>>3),ch=lane&7; const u32x4 v=*(const u32x4*)(stg+row*64+ch*8); ATTN_STORE16(Ow+(long)row*DM+ch*8,v);} }
  asm volatile("s_waitcnt lgkmcnt(0)\n\ts_barrier":::"memory");
  #undef DMA_K
  #undef DMA_V
  #undef CMASK
  #undef START
  #undef RESC
  #undef ROT
  #undef BIASFILL
}
constexpr int ATTN_LDS_BYTES=LDS_BYTES;
struct AttnTensors { const bf16* Q; const bf16* K; const bf16* V; bf16* O; const float* CL; const float* GQ; const float* GK; };
struct AttnUnit { int bh; int qb; };
struct StaticOrder {
  int vcu,G;
  __device__ __forceinline__ explicit StaticOrder(int grid,int block):vcu((grid%8==0)?(block%8)*(grid/8)+block/8:block),G(grid){}
  __device__ __forceinline__ bool next(int i,AttnUnit&u)const{ const int p=vcu+G*(i>>1); if(p>=BATCH*NHEAD*NQB/2)return false; const int s=p&15; u.bh=p>>4; u.qb=(i&1)?31-s:s; return true; }
  __device__ __forceinline__ void a_ready(const AttnUnit&)const{}
  __device__ __forceinline__ void done(const AttnUnit&)const{}
};
template<class Sched,int THRL=16> __device__ __forceinline__ void attn_phase(char*lds,const AttnTensors&T,const Sched&S){
  AttnUnit u;
  for(int i=0;S.next(i,u);++i){ S.a_ready(u); attn_unit<THRL>(u.bh/NHEAD,u.bh%NHEAD,u.qb,T.Q,T.K,T.V,T.O,T.CL,T.GQ,T.GK,lds); S.done(u); }
}
template<int THRL=16> __device__ __forceinline__ void attn_phase_dyn(char*lds,const AttnTensors&T,unsigned*cnt,volatile __attribute__((address_space(3))) int*word,int myq){
  for(;;){
    if(threadIdx.x==0){ int got=-1;
      for(int k=0;k<8&&got<0;++k){ const int q=(myq+k)&7; const unsigned idx=__hip_atomic_fetch_add(cnt+64*q,1u,__ATOMIC_RELAXED,__HIP_MEMORY_SCOPE_AGENT); if(idx<64u)got=q*64+(int)idx; }
      *word=got; }
    __syncthreads();
    const int j=__builtin_amdgcn_readfirstlane(*word);
    if(j<0)break;
    const int q=j>>6,k=j&63,bh=2*q+(k&1),qb=31-(k>>1);
    attn_unit<THRL>(bh/NHEAD,bh%NHEAD,qb,T.Q,T.K,T.V,T.O,T.CL,T.GQ,T.GK,lds);
  }
  __syncthreads();
}
#undef SBAR
#undef WAIT_BAR
}
#include <hip/hip_cooperative_groups.h>
namespace cg = cooperative_groups;
constexpr int NWAVES = 8;
#ifndef REP_P0
#define REP_P0 1
#endif
#ifndef REP_T
#define REP_T 1
#endif
#ifndef REP_P1
#define REP_P1 1
#endif
#ifndef REP_ATT
#define REP_ATT 1
#endif
#ifndef REP_GATES
#define REP_GATES 1
#endif
#ifndef REP_P7F
#define REP_P7F 1
#endif
#ifndef REP_I3
#define REP_I3 1
#endif
#ifndef REP_P5
#define REP_P5 1
#endif
#ifndef PG8_ALIGN1
#define PG8_ALIGN1 PG8_ALIGN
#endif
#ifndef GATE_TAKE
#define GATE_TAKE 2
#endif
#ifndef REP_P6
#define REP_P6 1
#endif
constexpr int BATCH = 2, T = 8192, D = 1024, M = BATCH * T, DEPTH = 2;
constexpr int CC = 512, CW = 31, NH = 8, FF = 2816, INC = 4616, NIN = 19 * 256;
constexpr size_t MiB = 1u << 20;
constexpr size_t W_STRIDE = 32 * MiB, W_IN = 0, W_C = 10 * MiB, W_A = 11 * MiB, W_O = 12 * MiB, W_F = 14 * MiB, W_D = 26 * MiB;
constexpr size_t WS_XB = 64 * MiB, WS_GA = 96 * MiB, WS_GB = 128 * MiB, WS_Q = 160 * MiB, WS_K = 176 * MiB, WS_V = 192 * MiB, WS_G = 208 * MiB, WS_AC = 224 * MiB,
                 WS_SS = 240 * MiB, WS_LF = 241 * MiB, WS_CL = 242 * MiB, WS_CTL = 243 * MiB, WS_END = 244 * MiB;
constexpr size_t WS_HB = 96 * MiB;
static_assert(WS_HB + (size_t)M * FF * 2 <= WS_V && W_F + (size_t)2 * FF * D * 2 <= W_D && W_D + (size_t)D * FF * 2 <= W_STRIDE && (size_t)NIN * D * 2 <= W_C, "d_ws map");
constexpr int RING_BYTES = 131072, LDS_BYTES = 135168, LDS_BARST = RING_BYTES + 64;
constexpr size_t CTL_ZERO_BYTES = 65536;

#define LAS __attribute__((address_space(3)))
typedef unsigned short bf16;
typedef unsigned v4u __attribute__((ext_vector_type(4)));
typedef float f32x4 __attribute__((ext_vector_type(4)));
typedef float f32x2 __attribute__((ext_vector_type(2)));
#define LDS_WAIT() asm volatile("s_waitcnt lgkmcnt(0)" ::: "memory")
__device__ __forceinline__ unsigned f2bf(float f) { unsigned u = __builtin_bit_cast(unsigned, f); return (u + 0x7fffu + ((u >> 16) & 1u)) >> 16; }
__device__ __forceinline__ unsigned pk2(float lo, float hi) { return f2bf(lo) | (f2bf(hi) << 16); }
__device__ __forceinline__ float wave_sum(float v) {
#pragma unroll
    for (int o = 1; o < 64; o <<= 1) v += __shfl_xor(v, o);
    return v;
}
__device__ __forceinline__ void tr_item(const float* W, int ldw, int K, bf16* WT, int kb, int orow0, int src0, int valid, const float* gk, LAS float* scr, int lane) {
    const int k0 = 64 * kb, c = lane & 31;
    float v[32], gsc[32];
    const bool ok = c < valid;
#pragma unroll
    for (int i = 0; i < 32; ++i) { const int kk = 2 * i + (lane >> 5); v[i] = ok ? W[(size_t)(k0 + kk) * ldw + src0 + c] : 0.f; gsc[i] = gk ? gk[k0 + kk] : 1.0f; }
#pragma unroll
    for (int i = 0; i < 32; ++i) { const int kk = 2 * i + (lane >> 5); scr[kk * 33 + c] = v[i] * gsc[i]; }
    LDS_WAIT(); asm volatile("" ::: "memory");
    const int ch = lane & 7;
#pragma unroll
    for (int j = 0; j < 4; ++j) { const int n = (lane >> 3) + 8 * j; const LAS float* s = scr + (8 * ch) * 33 + n;
        v4u o; o.x = pk2(s[0 * 33], s[1 * 33]); o.y = pk2(s[2 * 33], s[3 * 33]); o.z = pk2(s[4 * 33], s[5 * 33]); o.w = pk2(s[6 * 33], s[7 * 33]);
        *(v4u*)(WT + (size_t)(orow0 + n) * K + k0 + 8 * ch) = o; }
    LDS_WAIT(); asm volatile("" ::: "memory");
}
__device__ __forceinline__ int src_in(int ob, int& valid) {
    const int p = ob >> 3, sub = ob & 7; valid = 32;
    if (p < 4) return sub < 4 ? 128 * p + 32 * sub : 512 + 128 * p + 32 * (sub - 4);
    if (p < 8) { const int base = p < 6 ? 1024 : 1536, hh = 4 * (p & 1) + (sub & 3), bj = sub >> 2; return base + hh * 64 + 32 * bj; }
    if (p < 10) return 2048 + 256 * (p - 8) + 32 * sub;
    if (p == 10) { if (sub == 0) { valid = 8; return 2560; } valid = 0; return 0; }
    if (p < 15) return 2568 + 256 * (p - 11) + 32 * sub;
    return 3592 + 256 * (p - 15) + 32 * sub;
}
__device__ __forceinline__ int src_ffn(int ob) { const int p = ob >> 3, sub = ob & 7; return sub < 4 ? 128 * p + 32 * sub : FF + 128 * p + 32 * (sub - 4); }

#define XB_TMO      128
#define XB_XCNT(j)  (256  + 64 * (j))
#define XB_XSUB(j)  (1280 + 64 * (j))
#define XB_XGEN(j)  (2304 + 64 * (j))
#define XB_TOP      3328
#define XB_TOPGEN   3392
#define XCD_BAR_WORDS 3456
#define XB_SPIN_CAP (1u << 18)

__device__ __forceinline__ unsigned xb_ld(unsigned* p)              { return __hip_atomic_load(p, __ATOMIC_RELAXED, __HIP_MEMORY_SCOPE_AGENT); }
__device__ __forceinline__ unsigned xb_add(unsigned* p, unsigned v) { return __hip_atomic_fetch_add(p, v, __ATOMIC_RELAXED, __HIP_MEMORY_SCOPE_AGENT); }
__device__ __forceinline__ unsigned xb_xcc_id() { return (unsigned)__builtin_amdgcn_s_getreg((3 << 11) | 20) & 0xFu; }
#define XB_SPIN(cond, bar) do { unsigned _sp = 0; while (cond) { __builtin_amdgcn_s_sleep(1); \
    if ((++_sp & 255u) == 0u) { if (xb_ld(&(bar)[XB_TMO])) break; if (_sp > XB_SPIN_CAP) { atomicAdd(&(bar)[XB_TMO], 1u); break; } } } } while (0)

struct XcdBarrier {
    unsigned* bar; unsigned x;
    volatile LAS unsigned* st;
};

__device__ __forceinline__ XcdBarrier xcd_barrier_post(unsigned* bar, volatile LAS unsigned* st) {
    XcdBarrier b; b.bar = bar; b.x = xb_xcc_id(); b.st = st;
    if (threadIdx.x == 0) (void)xb_add(&bar[XB_XCNT(b.x)], 1u);
    return b;
}
__device__ __forceinline__ void xcd_barrier_complete(unsigned* bar, unsigned x, unsigned& nloc, unsigned& nx) {
    const unsigned G = gridDim.x * gridDim.y * gridDim.z;
    unsigned sum, cnt, mine, sp = 0u;
    for (;;) {
        sum = 0u; cnt = 0u; mine = 0u;
#pragma unroll
        for (unsigned j = 0; j < 16; ++j) { const unsigned c = xb_ld(&bar[XB_XCNT(j)]); sum += c; cnt += (c > 0u) ? 1u : 0u; mine = (j == x) ? c : mine; }
        if (sum == G) break;
        __builtin_amdgcn_s_sleep(1);
        if ((++sp & 255u) == 0u) { if (xb_ld(&bar[XB_TMO])) break; if (sp > XB_SPIN_CAP) { atomicAdd(&bar[XB_TMO], 1u); break; } }
    }
    nloc = mine > 0u ? mine : 1u; nx = cnt > 0u ? cnt : 1u;
}

__device__ __forceinline__ void xcd_barrier(const XcdBarrier& b) {
    asm volatile("s_waitcnt vmcnt(0)" ::: "memory");
    __syncthreads();
    if (threadIdx.x == 0) {
        unsigned* bar = b.bar;
        __builtin_amdgcn_s_waitcnt(0);
        unsigned nloc = b.st[0], nx = b.st[1];
        if (nloc == 0u) { xcd_barrier_complete(bar, b.x, nloc, nx); b.st[0] = nloc; b.st[1] = nx; }
        const unsigned old = xb_add(&bar[XB_XSUB(b.x)], 1u);
        const unsigned gen = old / nloc;
        if (old + 1u == (gen + 1u) * nloc) {
            __builtin_amdgcn_fence(__ATOMIC_RELEASE, "agent");
            asm volatile("s_waitcnt vmcnt(0)" ::: "memory");
            const unsigned og = xb_add(&bar[XB_TOP], 1u);
            const unsigned tg = og / nx;
            if (og + 1u == (tg + 1u) * nx) xb_add(&bar[XB_TOPGEN], 1u);
            else XB_SPIN(xb_ld(&bar[XB_TOPGEN]) == tg, bar);
            __builtin_amdgcn_fence(__ATOMIC_ACQUIRE, "agent");
            xb_add(&bar[XB_XGEN(b.x)], 1u);
            asm volatile("s_waitcnt vmcnt(0)" ::: "memory");
        } else {
            XB_SPIN(xb_ld(&bar[XB_XGEN(b.x)]) == gen, bar);
            __builtin_amdgcn_fence(__ATOMIC_ACQUIRE, "agent");
            asm volatile("s_waitcnt vmcnt(0)" ::: "memory");
        }
    }
    __syncthreads();
}

struct Args { const float* in[16]; float* out; unsigned char* ws; };

__device__ __forceinline__ void scan_seq(LAS unsigned char* lds, int tid, const float* lf, float* cl) {
    const int lane = tid & 63, wave = tid >> 6;
    f32x4 v[4];
#pragma unroll
    for (int j = 0; j < 4; ++j) v[j] = *(const f32x4*)(lf + tid * 16 + 4 * j);
    float run = 0.f;
#pragma unroll
    for (int j = 0; j < 4; ++j)
#pragma unroll
        for (int e = 0; e < 4; ++e) { run += v[j][e]; v[j][e] = run; }
    float inc = run;
#pragma unroll
    for (int o = 1; o < 64; o <<= 1) { const float y = __shfl_up(inc, o); if (lane >= o) inc += y; }
    LAS float* wt = (LAS float*)lds;
    if (lane == 63) wt[wave] = inc;
    __syncthreads();
    float off = inc - run;
    for (int w = 0; w < wave; ++w) off += wt[w];
#pragma unroll
    for (int j = 0; j < 4; ++j) { *(f32x4*)(cl + tid * 16 + 4 * j) = (v[j] + off) * 1.4426950408889634f; }
    __syncthreads();
}

#define XB_LSUB(j)  (3584 + 64 * (j))
#define XB_LGEN(j)  (4608 + 64 * (j))
#define XB_RMAXA(r) (5696 + 64 * (r))
#define XB_RMAXB(r) (6208 + 64 * (r))
__device__ __forceinline__ void xcd_local_barrier(const XcdBarrier& b, unsigned nloc) {
    asm volatile("s_waitcnt vmcnt(0)" ::: "memory");
    __syncthreads();
    if (threadIdx.x == 0) {
        unsigned* bar = b.bar;
        const unsigned old = xb_add(&bar[XB_LSUB(b.x)], 1u);
        const unsigned gen = old / nloc;
        if (old + 1u == (gen + 1u) * nloc) xb_add(&bar[XB_LGEN(b.x)], 1u);
        else XB_SPIN(xb_ld(&bar[XB_LGEN(b.x)]) == gen, bar);
        __builtin_amdgcn_fence(__ATOMIC_ACQUIRE, "agent");
        asm volatile("s_waitcnt vmcnt(0)" ::: "memory");
    }
    __syncthreads();
}
struct OneUnit { int q, k0, n;
    __device__ __forceinline__ bool next(int i, pg8::Unit& u) const { if (i >= n) return false; const int k = k0 + i; u.pm = 8 * q + (k & 7); u.pn = k >> 3; return true; }
    __device__ __forceinline__ void a_ready(const pg8::Unit&) const {}
    __device__ __forceinline__ void done(const pg8::Unit&) const {} };
__device__ __forceinline__ int claim_unit(unsigned* cnt, int myq, int per_q, volatile LAS int* word, unsigned take = 1u) {
    if (threadIdx.x == 0) { int got = -1;
        for (int k = 0; k < 8 && got < 0; ++k) { const int q = (myq + k) & 7; const unsigned idx = __hip_atomic_fetch_add(cnt + 64 * q, take, __ATOMIC_RELAXED, __HIP_MEMORY_SCOPE_AGENT); if (idx < (unsigned)per_q) got = q * per_q + (int)idx; }
        *word = got; }
    __syncthreads();
    const int j = __builtin_amdgcn_readfirstlane(*word);
    __syncthreads();
    return j;
}
__device__ __forceinline__ void conv_phase(LAS unsigned char* lds, unsigned* cnt, int myq, volatile LAS int* word, int tid, const bf16* Gin, const float* wdw, const float* bdw, const float* gln, const float* bln, bf16* AC) {
    LAS unsigned* lin = (LAS unsigned*)lds;
    LAS float* lout = (LAS float*)(lds + 63488);
    const int lane = tid & 63, wave = tid >> 6, cp = tid & 255, th = tid >> 8;
    f32x2 wv[31];
#pragma unroll
    for (int k = 0; k < 31; ++k) wv[k] = *(const f32x2*)(wdw + k * 512 + 2 * cp);
    const f32x2 bb = *(const f32x2*)(bdw + 2 * cp);
    const f32x4 g0 = *(const f32x4*)(gln + 8 * lane), g1 = *(const f32x4*)(gln + 8 * lane + 4), b0 = *(const f32x4*)(bln + 8 * lane), b1 = *(const f32x4*)(bln + 8 * lane + 4);
    for (;;) {
        const int pass = claim_unit(cnt, myq, (M / 32) / 8, word); if (pass < 0) break;
        const int m0 = pass * 32, tb = m0 & (T - 1);
        for (int c = tid; c < 62 * 64; c += NWAVES * 64) { const int r = c >> 6, ch = c & 63; v4u v = (v4u){0u, 0u, 0u, 0u};
            if (tb - 30 + r >= 0) v = *(const v4u*)(Gin + (size_t)(m0 - 30 + r) * 512 + ch * 8);
            *(LAS v4u*)(lin + r * 256 + ch * 4) = v; }
        __syncthreads();
        f32x2 av[16];
#pragma unroll
        for (int o = 0; o < 16; ++o) av[o] = bb;
#pragma unroll
        for (int r = 0; r < 46; ++r) { const unsigned v = lin[(16 * th + r) * 256 + cp]; const f32x2 xv = (f32x2){__uint_as_float(v << 16), __uint_as_float(v & 0xffff0000u)};
#pragma unroll
            for (int o = 0; o < 16; ++o) { const int k = r - o; if (k >= 0 && k < 31) av[o] = __builtin_elementwise_fma(wv[k], xv, av[o]); } }
#pragma unroll
        for (int o = 0; o < 16; ++o) *(LAS f32x2*)(lout + (16 * th + o) * 512 + 2 * cp) = av[o];
        __syncthreads();
#pragma unroll
        for (int i = 0; i < 4; ++i) { const int tok = 4 * wave + i;
            f32x4 x0 = *(const LAS f32x4*)(lout + tok * 512 + 8 * lane), x1 = *(const LAS f32x4*)(lout + tok * 512 + 8 * lane + 4);
            const float mean = wave_sum(((x0[0] + x0[1]) + (x0[2] + x0[3])) + ((x1[0] + x1[1]) + (x1[2] + x1[3]))) * (1.0f / 512.0f);
            x0 = x0 - mean; x1 = x1 - mean;
            const float var = wave_sum(((x0[0] * x0[0] + x0[1] * x0[1]) + (x0[2] * x0[2] + x0[3] * x0[3])) + ((x1[0] * x1[0] + x1[1] * x1[1]) + (x1[2] * x1[2] + x1[3] * x1[3]))) * (1.0f / 512.0f);
            const float rstd = __builtin_amdgcn_rsqf(var + 1e-6f);
            x0 = x0 * rstd * g0 + b0; x1 = x1 * rstd * g1 + b1;
#pragma unroll
            for (int e = 0; e < 4; ++e) { x0[e] = x0[e] * pg8::sigm(x0[e]); x1[e] = x1[e] * pg8::sigm(x1[e]); }
            *(pg8::u32x4*)(AC + (size_t)(m0 + tok) * 512 + 8 * lane) = pg8::pack8(x0, x1); }
        __syncthreads();
    }
}
constexpr int I_IN = (D / 64) * (NIN / 32), I_C = (CC / 64) * (D / 32), I_O = (D / 64) * (D / 32), I_F = (D / 64) * (2 * FF / 32), I_D = (FF / 64) * (D / 32);
constexpr int I_L = I_IN + 2 * I_C + I_O + I_F + I_D, W_ITEMS = I_L;
__device__ __forceinline__ void weight_item(const Args& args, unsigned char* ws, int it, LAS float* scr, int lane) {
            const int l = it / I_L; int r = it % I_L; unsigned char* wl = ws + (size_t)l * W_STRIDE;
            if (r < I_IN) { const int nblk = NIN / 32, kb = r / nblk, ob = r % nblk; int valid; const int s0 = src_in(ob, valid);
                tr_item(args.in[2] + (size_t)l * D * INC, INC, D, (bf16*)(wl + W_IN), kb, 32 * ob, s0, valid, args.in[1] + l * D, scr, lane); return; } r -= I_IN;
            if (r < I_C) { const int nblk = D / 32, kb = r / nblk, ob = r % nblk;
                tr_item(args.in[8] + (size_t)l * CC * D, D, CC, (bf16*)(wl + W_C), kb, 32 * ob, 32 * ob, 32, nullptr, scr, lane); return; } r -= I_C;
            if (r < I_C) { const int nblk = D / 32, kb = r / nblk, ob = r % nblk;
                tr_item(args.in[11] + (size_t)l * CC * D, D, CC, (bf16*)(wl + W_A), kb, 32 * ob, 32 * ob, 32, nullptr, scr, lane); return; } r -= I_C;
            if (r < I_O) { const int nblk = D / 32, kb = r / nblk, ob = r % nblk;
                tr_item(args.in[12] + (size_t)l * D * D, D, D, (bf16*)(wl + W_O), kb, 32 * ob, 32 * ob, 32, nullptr, scr, lane); return; } r -= I_O;
            if (r < I_F) { const int nblk = 2 * FF / 32, kb = r / nblk, ob = r % nblk;
                tr_item(args.in[14] + (size_t)l * D * 2 * FF, 2 * FF, D, (bf16*)(wl + W_F), kb, 32 * ob, src_ffn(ob), 32, args.in[13] + l * D, scr, lane); return; } r -= I_F;
            { const int nblk = D / 32, kb = r / nblk, ob = r % nblk;
                tr_item(args.in[15] + (size_t)l * FF * D, D, FF, (bf16*)(wl + W_D), kb, 32 * ob, 32 * ob, 32, nullptr, scr, lane); }
}

__global__ void __launch_bounds__(NWAVES * 64, 2) fwd_kernel(Args args) {
    extern __shared__ __attribute__((aligned(16))) unsigned char lds_raw[];
    cg::grid_group grid = cg::this_grid();
    LAS unsigned char* lds = (LAS unsigned char*)lds_raw;
    if (threadIdx.x < 2) ((volatile LAS unsigned*)(lds + LDS_BARST))[threadIdx.x] = 0u;
    __syncthreads();
    const XcdBarrier bar = xcd_barrier_post((unsigned*)(args.ws + WS_CTL), (volatile LAS unsigned*)(lds + LDS_BARST));
    if (threadIdx.x == 0) { unsigned* cw = (unsigned*)(args.ws + WS_CTL); __hip_atomic_fetch_max(cw + XB_RMAXA(blockIdx.x & 7u), bar.x + 1u, __ATOMIC_RELAXED, __HIP_MEMORY_SCOPE_AGENT); __hip_atomic_fetch_max(cw + XB_RMAXB(blockIdx.x & 7u), 16u - bar.x, __ATOMIC_RELAXED, __HIP_MEMORY_SCOPE_AGENT); }
    if (args.ws == nullptr) grid.sync();
#define GRID_SYNC() xcd_barrier(bar)
    const int tid = threadIdx.x, lane = tid & 63, wave = __builtin_amdgcn_readfirstlane(tid >> 6);
    const int G = gridDim.x, bx = blockIdx.x, vcu = (G % 8 == 0) ? (bx % 8) * (G / 8) + bx / 8 : bx;
    unsigned char* ws = args.ws;
    const float* x = args.in[0]; float* out = args.out;
    bf16* XB = (bf16*)(ws + WS_XB); bf16* GA = (bf16*)(ws + WS_GA); bf16* GB = (bf16*)(ws + WS_GB); bf16* Qb = (bf16*)(ws + WS_Q); bf16* Kb = (bf16*)(ws + WS_K); bf16* Vb = (bf16*)(ws + WS_V);
    bf16* Gb = (bf16*)(ws + WS_G); bf16* AC = (bf16*)(ws + WS_AC); bf16* HB = (bf16*)(ws + WS_HB);
    float* SS = (float*)(ws + WS_SS); float* LF = (float*)(ws + WS_LF); float* CL = (float*)(ws + WS_CL);

    for (int rep0 = 0; rep0 < REP_P0; ++rep0) {
        int tidP = threadIdx.x; asm volatile("" : "+v"(tidP)); const int lane = tidP & 63;
        LAS float* scr = (LAS float*)(lds + wave * 16384);
        const int gw = vcu * NWAVES + wave, NGW = G * NWAVES;
        const bool split = (G == 256);
        for (int it = gw; it < (split ? W_ITEMS : DEPTH * W_ITEMS); it += NGW) weight_item(args, ws, it, scr, lane);
        for (int m0 = gw; m0 < M; m0 += 4 * NGW) {
            f32x4 v[4][4];
#pragma unroll
            for (int r = 0; r < 4; ++r) { const int m = m0 + r * NGW; if (m < M) { const f32x4* xr = (const f32x4*)(x + (size_t)m * D) + lane;
#pragma unroll
                for (int j = 0; j < 4; ++j) v[r][j] = xr[64 * j]; } }
#pragma unroll
            for (int r = 0; r < 4; ++r) { const int m = m0 + r * NGW; if (m < M) { float s = 0.f;
#pragma unroll
                for (int j = 0; j < 4; ++j) s += (v[r][j][0] * v[r][j][0] + v[r][j][1] * v[r][j][1]) + (v[r][j][2] * v[r][j][2] + v[r][j][3] * v[r][j][3]);
                s = wave_sum(s);
                unsigned long long* o8 = (unsigned long long*)(XB + (size_t)m * D) + lane;
#pragma unroll
                for (int j = 0; j < 4; ++j) o8[64 * j] = (unsigned long long)pk2(v[r][j][0], v[r][j][1]) | ((unsigned long long)pk2(v[r][j][2], v[r][j][3]) << 32);
                if (lane < 16) SS[(size_t)m * 16 + lane] = lane == 0 ? s : 0.f; } }
        }
    }
    GRID_SYNC();
    if (threadIdx.x == 0) { unsigned* cw = (unsigned*)(args.ws + WS_CTL); int bad = (gridDim.x != 256u);
        for (unsigned r = 0; r < 8; ++r) bad |= (xb_ld(cw + XB_RMAXA(r)) + xb_ld(cw + XB_RMAXB(r)) != 17u);
        for (unsigned j = 0; j < 16; ++j) { const unsigned c = xb_ld(cw + XB_XCNT(j)); bad |= (c != 0u && c != 32u); }
        *(volatile LAS int*)(lds + LDS_BARST + 48) = bad; }
    __syncthreads();
    const bool aligned = __builtin_amdgcn_readfirstlane(*(volatile LAS int*)(lds + LDS_BARST + 48)) == 0;
#define SEAM_LOCAL() do { if (aligned) xcd_local_barrier(bar, 32u); else xcd_barrier(bar); } while (0)
#ifdef PROBE_ALIGNED
    if (!aligned) for (int eb = 0; eb < 20; ++eb) GRID_SYNC();
#endif

    for (int l = 0; l < DEPTH; ++l) {
        unsigned char* wl = ws + (size_t)l * W_STRIDE;
        for (int rep1 = 0; rep1 < REP_P1; ++rep1) {
            pg8::Gemm g{XB, (const bf16*)(wl + W_IN), M, 11 * 256, D}; pg8::StaticOrder S; S.init(M, 11 * 256, G, bx);
            pg8::EpiInProj E{SS, Gb, Qb, Kb, Vb, LF, args.in[9] + l * 64, args.in[10] + l * 64, args.in[3] + l * NH, attn_body::C2};
            pg8::gemm_phase<pg8::EpiInProj, pg8::StaticOrder, PG8_ALIGN, PG8_SP2>(lds, g, S, E);
        }
        for (int stage = 0; stage < 2; ++stage) {
            if (stage == 1) {
                GRID_SYNC();
                const attn_body::AttnTensors AT{(const attn_body::bf16*)Qb, (const attn_body::bf16*)Kb, (const attn_body::bf16*)Vb, (attn_body::bf16*)Qb, LF, args.in[9] + l * 64, args.in[10] + l * 64};
                attn_body::attn_phase_dyn((char*)lds_raw, AT, (unsigned*)(args.ws + WS_CTL) + 8192 + l * 1024, (volatile LAS int*)(lds + LDS_BARST + 32), (int)bar.x & 7);
            }
#ifndef STAGE0_GATES
#define STAGE0_GATES 1
#endif
            int budget = stage == 0 ? ((G == 256 && bx >= 192) ? STAGE0_GATES : 0) : (1 << 30);
            while (budget-- > 0) {
                const unsigned take = stage == 0 ? 1u : (unsigned)GATE_TAKE;
                const int j = claim_unit((unsigned*)(args.ws + WS_CTL) + 8192 + 512 + l * 1024, bx & 7  , 64, (volatile LAS int*)(lds + LDS_BARST + 32), take);
                if (j < 0) break;
                const int q = j >> 6, k = j & 63, nu = (64 - k) < (int)take ? (64 - k) : (int)take;
                pg8::Gemm g{XB, (const bf16*)(wl + W_IN) + (size_t)11 * 256 * D, M, 8 * 256, D}; const OneUnit S{q, k, nu};
                pg8::EpiGateSig E{SS, GA, GB};
                pg8::gemm_phase<pg8::EpiGateSig, OneUnit, PG8_ALIGN, PG8_SP2>(lds, g, S, E);
            }
            if (stage == 1) {
                int tidT = threadIdx.x; asm volatile("" : "+v"(tidT));
                conv_phase(lds, (unsigned*)(args.ws + WS_CTL) + 8192 + 2048 + l * 1024, bx & 7, (volatile LAS int*)(lds + LDS_BARST + 32), tidT, Gb, args.in[4] + (size_t)l * CW * CC, args.in[5] + l * CC, args.in[6] + l * CC, args.in[7] + l * CC, AC);
            }
        }
        GRID_SYNC();
        {
            static_assert((WS_AC - WS_Q) % ((size_t)256 * CC * 2) == 0 && W_A == W_C + (size_t)D * CC * 2, "the pair order reaches O and the attn-out weights through unit indices");
            constexpr int APM_OFF = (int)((WS_AC - WS_Q) / ((size_t)256 * CC * 2));
            pg8::Gemm g{AC, (const bf16*)(wl + W_C), M, D, CC}; pg8::PairOrder S; S.s.init(M, D, G, bx); S.apm_off = APM_OFF;
            pg8::EpiGatePair E{GA, GB, APM_OFF};
            pg8::gemm_phase<pg8::EpiGatePair, pg8::PairOrder, PG8_ALIGN, PG8_SP2>(lds, g, S, E);
        }
        SEAM_LOCAL();
        {
            pg8::Gemm g{GB, (const bf16*)(wl + W_O), M, D, D}; pg8::StaticOrder S; S.init(M, D, G, bx);
            for (int rep5 = 0; rep5 < REP_P5; ++rep5) { const bool lastr = rep5 + 1 == REP_P5;
            pg8::EpiResid<false> E{out, XB, SS, lastr ? XB : (bf16*)out, lastr ? SS : out + (size_t)M * D / 2};
            pg8::gemm_phase<pg8::EpiResid<false>, pg8::StaticOrder, PG8_ALIGN1, PG8_SP2>(lds, g, S, E); }
        }
        GRID_SYNC();
        for (int rep6 = 0; rep6 < REP_P6; ++rep6) {
            pg8::Gemm g{XB, (const bf16*)(wl + W_F), M, 2 * FF, D}; pg8::StaticOrder S; S.init(M, 2 * FF, G, bx);
            pg8::EpiSwiglu E{SS, HB};
            pg8::gemm_phase<pg8::EpiSwiglu, pg8::StaticOrder, PG8_ALIGN, PG8_SP2>(lds, g, S, E);
#ifdef REP_P6_BAR
            if (rep6 + 1 < REP_P6) GRID_SYNC();
#endif
        }
        if (l == 0 && G == 256 && bx >= 128) {
            int tidW = threadIdx.x; asm volatile("" : "+v"(tidW));
            LAS float* scr = (LAS float*)(lds + wave * 16384);
            for (int it = W_ITEMS + (bx - 128) * NWAVES + wave; it < DEPTH * W_ITEMS; it += 128 * NWAVES) weight_item(args, ws, it, scr, tidW & 63);
        }
        SEAM_LOCAL();
        {
            pg8::Gemm g{HB, (const bf16*)(wl + W_D), M, D, FF}; pg8::StaticOrder S; S.init(M, D, G, bx);
            if (l + 1 < DEPTH) { pg8::EpiResid<false> E{out, XB, SS, XB, SS}; pg8::gemm_phase<pg8::EpiResid<false>, pg8::StaticOrder, PG8_ALIGN1, PG8_SP2>(lds, g, S, E); }
            else { for (int rep7 = 0; rep7 < REP_P7F; ++rep7) { pg8::EpiResid<true> E{out, XB, SS, XB, SS}; pg8::gemm_phase<pg8::EpiResid<true>, pg8::StaticOrder, PG8_ALIGN1, PG8_SP2>(lds, g, S, E); } }
        }
        if (l + 1 < DEPTH) GRID_SYNC();
#ifdef EXTRA_BARS
        for (int eb = 0; eb < EXTRA_BARS; ++eb) GRID_SYNC();
#endif
    }
}

extern "C" void kernel_launch(void* const* d_in, const int* in_sizes, int n_in, void* d_out, int out_size, void* d_ws, size_t ws_size, hipStream_t stream) {
    static int grid = 0;
    if (grid == 0) {
        if (n_in != 16 || in_sizes[0] != M * D || out_size != M * D || ws_size < WS_END) { fprintf(stderr, "kernel_launch: unexpected shapes (n_in %d, in0 %d, out %d, ws %zu)\n", n_in, n_in > 0 ? in_sizes[0] : -1, out_size, ws_size); grid = -1; return; }
        int dev = 0, cus = 0, per_cu = 0;
        if (hipGetDevice(&dev) != hipSuccess || hipDeviceGetAttribute(&cus, hipDeviceAttributeMultiprocessorCount, dev) != hipSuccess) { grid = -1; return; }
        if (hipFuncSetAttribute((const void*)fwd_kernel, hipFuncAttributeMaxDynamicSharedMemorySize, LDS_BYTES) != hipSuccess) { fprintf(stderr, "kernel_launch: hipFuncSetAttribute failed\n"); grid = -1; return; }
        if (hipOccupancyMaxActiveBlocksPerMultiprocessor(&per_cu, (const void*)fwd_kernel, NWAVES * 64, LDS_BYTES) != hipSuccess || per_cu < 1) { fprintf(stderr, "kernel_launch: occupancy query says %d\n", per_cu); per_cu = 1; }
        (void)hipGetLastError();
        grid = cus * 1;
        (void)per_cu;
    }
    if (grid < 0) return;
    if (hipMemsetAsync((char*)d_ws + WS_CTL, 0, CTL_ZERO_BYTES, stream) != hipSuccess) { fprintf(stderr, "kernel_launch: hipMemsetAsync failed\n"); return; }
    Args a{};
    for (int i = 0; i < 16; ++i) a.in[i] = (const float*)d_in[i];
    a.out = (float*)d_out; a.ws = (unsigned char*)d_ws;
    void* params[] = {&a};
    const hipError_t le = hipLaunchCooperativeKernel((const void*)fwd_kernel, dim3(grid), dim3(NWAVES * 64), params, LDS_BYTES, stream);
    if (le != hipSuccess) fprintf(stderr, "kernel_launch: cooperative launch failed: %s (grid %d)\n", hipGetErrorName(le), grid);
}
```

```cpp
#include <hip/hip_runtime.h>
#include <cstdio>
#include <cstdint>
namespace pg8 {
#define PG8_LAS __attribute__((address_space(3)))
typedef unsigned short bf16_t;
typedef short bf16x8 __attribute__((ext_vector_type(8)));
typedef float f32x4 __attribute__((ext_vector_type(4)));
typedef unsigned u32x4 __attribute__((ext_vector_type(4)));
constexpr int BM = 256, BK = 64, HALF = 128, HTB = HALF * BK * 2  , STAGE_BYTES = 8 * HTB, NXCD = 8, WGM = 8;

__host__ __device__ __forceinline__ int lds_byte(int r, int c) { const int st = (r >> 4) * 2 + (c >> 5), rr = r & 15, cc = c & 31, ob = rr * 64 + cc * 2; return st * 1024 + (ob ^ (((ob >> 9) & 1) << 5)); }
__host__ __device__ __forceinline__ void stage_rc(int b, int& R, int& C) { const int st = b / 1024, sb = b % 1024, swz = sb ^ (((sb >> 9) & 1) << 5); R = (st >> 1) * 16 + swz / 64; C = (st & 1) * 32 + (swz % 64) / 2; }
__host__ __device__ __forceinline__ int perm32(int rho) { const int n = rho >> 4, i = rho & 15; return 8 * (i >> 2) + 4 * n + (i & 3); }

struct Unit { int pm, pn; };
struct Gemm { const bf16_t* A; const bf16_t* Bt; int M, N, K; };

struct StaticOrder {
    int nM, nN, nwg, G, c;
    __host__ __device__ void init(int M, int N, int G_, int c_) { nM = M / BM; nN = N / BM; nwg = nM * nN; G = G_; c = c_; }
    __host__ __device__ bool next(int i, Unit& u) const {
        const long L = (long)i * G + c; if (L >= nwg) return false;
        int wgid = (int)L; { const int q = nwg / NXCD, r = nwg % NXCD, xcd = wgid % NXCD, off = wgid / NXCD; wgid = (xcd < r ? xcd * (q + 1) : r * (q + 1) + (xcd - r) * q) + off; }
        const int nig = WGM * nN, gid = wgid / nig, fm = gid * WGM, gsz = (nM - fm) < WGM ? (nM - fm) : WGM;
        u.pm = fm + ((wgid % nig) % gsz); u.pn = (wgid % nig) / gsz; return true;
    }
    __device__ __forceinline__ void a_ready(const Unit&) const {}
    __device__ __forceinline__ void done(const Unit&) const {}
};

typedef float f32x2cv __attribute__((ext_vector_type(2))); typedef __bf16 bf16x2cv __attribute__((ext_vector_type(2)));
__device__ __forceinline__ unsigned cvt_pk_bf16(float lo, float hi) { const f32x2cv v = {lo, hi}; const bf16x2cv b = __builtin_convertvector(v, bf16x2cv); return __builtin_bit_cast(unsigned, b); }
typedef float f32x2 __attribute__((ext_vector_type(2)));
typedef float f32x2 __attribute__((ext_vector_type(2)));
__device__ __forceinline__ float bf_lo(unsigned u) { return __uint_as_float(u << 16); }
__device__ __forceinline__ float bf_hi(unsigned u) { return __uint_as_float(u & 0xffff0000u); }
__device__ __forceinline__ float sigm(float x) { return __builtin_amdgcn_rcpf(1.0f + __expf(-x)); }
__device__ __forceinline__ u32x4 pack8(const f32x4 a, const f32x4 b) { u32x4 w; w.x = cvt_pk_bf16(a[0], a[1]); w.y = cvt_pk_bf16(a[2], a[3]); w.z = cvt_pk_bf16(b[0], b[1]); w.w = cvt_pk_bf16(b[2], b[3]); return w; }
__device__ __forceinline__ void unpack8(const u32x4 w, f32x4& a, f32x4& b) { a = (f32x4){bf_lo(w.x), bf_hi(w.x), bf_lo(w.y), bf_hi(w.y)}; b = (f32x4){bf_lo(w.z), bf_hi(w.z), bf_lo(w.w), bf_hi(w.w)}; }
__device__ __forceinline__ float row_inv(const float* ss, int row) {
    const f32x4* p = (const f32x4*)(ss + (size_t)row * 16);
    const f32x4 a = p[0], b = p[1], c = p[2], d = p[3];
    const float s = (((a[0] + a[1]) + (a[2] + a[3])) + ((b[0] + b[1]) + (b[2] + b[3]))) + (((c[0] + c[1]) + (c[2] + c[3])) + ((d[0] + d[1]) + (d[2] + d[3])));
    return __builtin_amdgcn_rsqf(s * (1.0f / 1024.0f) + 1e-6f);
}

struct EpiGateSig {
    static constexpr bool PERM = true, AFTER_DRAIN = false;
    const float* ss; bf16_t *GA, *GB;
    __device__ __forceinline__ void operator()(const f32x4 (&acc)[2][2][4][2], const Unit& u, int wr, int wc, int fr, int fq) const {
        const int p = u.pn; const int rowb = u.pm * BM + wr * 64 + fr;
        bf16_t* O = p < 4 ? GA : GB; const int cb = (p & 3) * 256;
#pragma unroll
        for (int ai = 0; ai < 2; ++ai)
#pragma unroll
            for (int m = 0; m < 4; ++m) { const int row = rowb + ai * HALF + m * 16; const float inv = row_inv(ss, row);
#pragma unroll
                for (int bj = 0; bj < 2; ++bj) { f32x4 o[2];
#pragma unroll
                    for (int n = 0; n < 2; ++n) { const f32x4 v = acc[ai][bj][m][n] * inv;
#pragma unroll
                        for (int e = 0; e < 4; ++e) o[n][e] = sigm(v[e]); }
                    *(u32x4*)(O + (size_t)row * 1024 + cb + bj * HALF + wc * 32 + fq * 8) = pack8(o[0], o[1]); } }
    }
};
struct EpiInProj {
    static constexpr bool PERM = true, AFTER_DRAIN = false;
    const float* ss; bf16_t *G, *Q, *K, *V; float* LF; const float *gq, *gk, *bfg; float c2;
    __device__ __forceinline__ void operator()(const f32x4 (&acc)[2][2][4][2], const Unit& u, int wr, int wc, int fr, int fq) const {
        const int p = u.pn; const int rowb = u.pm * BM + wr * 64 + fr;
        if (p < 4) {
#pragma unroll
            for (int ai = 0; ai < 2; ++ai)
#pragma unroll
                for (int m = 0; m < 4; ++m) { const int row = rowb + ai * HALF + m * 16; const float inv = row_inv(ss, row);
                    f32x4 o[2];
#pragma unroll
                    for (int n = 0; n < 2; ++n) { const f32x4 v = acc[ai][0][m][n] * inv, g = acc[ai][1][m][n] * inv;
#pragma unroll
                        for (int e = 0; e < 4; ++e) o[n][e] = v[e] * sigm(g[e]); }
                    *(u32x4*)(G + (size_t)row * 512 + p * 128 + wc * 32 + fq * 8) = pack8(o[0], o[1]); }
        } else if (p < 8) {
            const bool isq = p < 6; const float* gp = isq ? gq : gk; bf16_t* O = isq ? Q : K; const float sc = isq ? c2 : 1.0f; const int hh = 4 * (p & 1) + wc;
            f32x4 gv[2][2];
#pragma unroll
            for (int bj = 0; bj < 2; ++bj)
#pragma unroll
                for (int n = 0; n < 2; ++n) gv[bj][n] = *(const f32x4*)(gp + 32 * bj + 8 * fq + 4 * n) * sc;
#pragma unroll
            for (int ai = 0; ai < 2; ++ai)
#pragma unroll
                for (int m = 0; m < 4; ++m) { const int row = rowb + ai * HALF + m * 16; const float inv = row_inv(ss, row);
                    f32x4 a[2][2]; float s = 0.f;
#pragma unroll
                    for (int bj = 0; bj < 2; ++bj)
#pragma unroll
                        for (int n = 0; n < 2; ++n) { a[bj][n] = acc[ai][bj][m][n] * inv; s += (a[bj][n][0] * a[bj][n][0] + a[bj][n][1] * a[bj][n][1]) + (a[bj][n][2] * a[bj][n][2] + a[bj][n][3] * a[bj][n][3]); }
                    s += __shfl_xor(s, 16); s += __shfl_xor(s, 32);
                    const float rinv = __builtin_amdgcn_rsqf(s * (1.0f / 64.0f) + 1e-6f);
#pragma unroll
                    for (int bj = 0; bj < 2; ++bj)
                        *(u32x4*)(O + (size_t)row * 512 + hh * 64 + 32 * bj + 8 * fq) = pack8(a[bj][0] * rinv * gv[bj][0], a[bj][1] * rinv * gv[bj][1]); }
        } else if (p < 10) {
#pragma unroll
            for (int ai = 0; ai < 2; ++ai)
#pragma unroll
                for (int m = 0; m < 4; ++m) { const int row = rowb + ai * HALF + m * 16; const float inv = row_inv(ss, row);
#pragma unroll
                    for (int bj = 0; bj < 2; ++bj)
                        *(u32x4*)(V + (size_t)row * 512 + (p - 8) * 256 + bj * HALF + wc * 32 + fq * 8) = pack8(acc[ai][bj][m][0] * inv, acc[ai][bj][m][1] * inv); }
        } else {
            if (wc == 0 && fq == 0) {
#pragma unroll
                for (int ai = 0; ai < 2; ++ai)
#pragma unroll
                    for (int m = 0; m < 4; ++m) { const int row = rowb + ai * HALF + m * 16; const float inv = row_inv(ss, row); const int b = row >> 13, t = row & 8191;
#pragma unroll
                        for (int n = 0; n < 2; ++n)
#pragma unroll
                            for (int e = 0; e < 4; ++e) { const int h = 4 * n + e; const float z = acc[ai][0][m][n][e] * inv + bfg[h];
                                const float lf = fminf(z, 0.f) - __logf(1.0f + __expf(-fabsf(z)));
                                LF[(size_t)(b * 8 + h) * 8192 + t] = lf; } }
            }
        }
    }
};
struct EpiGatePair {
    static constexpr bool PERM = true, AFTER_DRAIN = false;
    bf16_t *GA, *GB; int apm_off;
    __device__ __forceinline__ void operator()(const f32x4 (&acc)[2][2][4][2], const Unit& u, int wr, int wc, int fr, int fq) const {
        const bool second = u.pn >= 4; const int pm = second ? u.pm + apm_off : u.pm, pn = second ? u.pn - 4 : u.pn;
        bf16_t* IO = second ? GB : GA;
        const int rowb = pm * BM + wr * 64 + fr, colb = pn * BM + wc * 32 + fq * 8;
#pragma unroll
        for (int ai = 0; ai < 2; ++ai)
#pragma unroll
            for (int m = 0; m < 4; ++m) { const int row = rowb + ai * HALF + m * 16;
#pragma unroll
                for (int bj = 0; bj < 2; ++bj) { const size_t off = (size_t)row * 1024 + colb + bj * HALF;
                    f32x4 g0, g1; unpack8(*(const u32x4*)(IO + off), g0, g1);
                    f32x4 o0 = g0 * acc[ai][bj][m][0], o1 = g1 * acc[ai][bj][m][1];
                    if (second) { f32x4 y0, y1; unpack8(*(const u32x4*)(GA + off), y0, y1); o0 += y0; o1 += y1; }
                    *(u32x4*)(IO + off) = pack8(o0, o1); } }
    }
};
struct PairOrder { StaticOrder s; int apm_off;
    __device__ __forceinline__ bool next(int i, Unit& u) const { if (i >= 2) return false; if (!s.next(0, u)) return false; if (i == 1) { u.pm -= apm_off; u.pn += 4; } return true; }
    __device__ __forceinline__ void a_ready(const Unit&) const {}
    __device__ __forceinline__ void done(const Unit&) const {} };
template <bool FINAL> struct EpiResid {
    static constexpr bool PERM = true, AFTER_DRAIN = false;
    float* Xout; bf16_t* XB; float* SS; bf16_t* XBo; float* SSo;
    __device__ __forceinline__ void operator()(const f32x4 (&acc)[2][2][4][2], const Unit& u, int wr, int wc, int fr, int fq) const {
        const int rowb = u.pm * BM + wr * 64 + fr, colb = u.pn * BM + wc * 32 + fq * 8;
#pragma unroll
        for (int ai = 0; ai < 2; ++ai)
#pragma unroll
            for (int m = 0; m < 4; ++m) { const int row = rowb + ai * HALF + m * 16; float s = 0.f;
#pragma unroll
                for (int bj = 0; bj < 2; ++bj) { const size_t off = (size_t)row * 1024 + colb + bj * HALF;
                    f32x4 x0, x1; unpack8(*(const u32x4*)(XB + off), x0, x1); x0 += acc[ai][bj][m][0]; x1 += acc[ai][bj][m][1];
                    if (FINAL) { *(f32x4*)(Xout + off) = x0; *(f32x4*)(Xout + off + 4) = x1; }
                    else { const u32x4 w = pack8(x0, x1); *(u32x4*)(XBo + off) = w; unpack8(w, x0, x1);
                        s += ((x0[0] * x0[0] + x0[1] * x0[1]) + (x0[2] * x0[2] + x0[3] * x0[3])) + ((x1[0] * x1[0] + x1[1] * x1[1]) + (x1[2] * x1[2] + x1[3] * x1[3])); } }
                if (!FINAL) { s += __shfl_xor(s, 16); s += __shfl_xor(s, 32);
                    if (fq == 0) SSo[(size_t)row * 16 + u.pn * 4 + wc] = s; } }
    }
};
struct EpiSwiglu {
    static constexpr bool PERM = true, AFTER_DRAIN = false;
    const float* ss; bf16_t* HB;
    __device__ __forceinline__ void operator()(const f32x4 (&acc)[2][2][4][2], const Unit& u, int wr, int wc, int fr, int fq) const {
        const int rowb = u.pm * BM + wr * 64 + fr;
#pragma unroll
        for (int ai = 0; ai < 2; ++ai)
#pragma unroll
            for (int m = 0; m < 4; ++m) { const int row = rowb + ai * HALF + m * 16; const float inv = row_inv(ss, row);
                f32x4 o[2];
#pragma unroll
                for (int n = 0; n < 2; ++n) { const f32x4 g = acc[ai][0][m][n] * inv, v = acc[ai][1][m][n] * inv;
#pragma unroll
                    for (int e = 0; e < 4; ++e) o[n][e] = g[e] * sigm(g[e]) * v[e]; }
                __builtin_nontemporal_store(pack8(o[0], o[1]), (u32x4*)(HB + (size_t)row * 2816 + u.pn * 128 + wc * 32 + fq * 8)); }
    }
};

template <class Epi, class Sched, bool ALIGN_EPI = false, bool SP2 = false>
__device__ __forceinline__ void gemm_phase(PG8_LAS unsigned char* lds, const Gemm g, const Sched& S, const Epi& E) {
    int tid = threadIdx.x; asm volatile("" : "+v"(tid));
    const int wid = __builtin_amdgcn_readfirstlane(tid >> 6), lane = tid & 63, wr = wid >> 2, wc = wid & 3, fr = lane & 15, fq = lane >> 4;
    const int K = g.K, nt = K / BK;
    unsigned voffA[2], voffB[2];
#pragma unroll
    for (int i = 0; i < 2; ++i) { int R, C; stage_rc(tid * 16 + i * 8192, R, C); const int Rb = Epi::PERM ? ((R & ~31) + perm32(R & 31)) : R;
        voffA[i] = (unsigned)(R * K + C) * 2u; voffB[i] = (unsigned)(Rb * K + C) * 2u; }
    const size_t kstep = (size_t)(BK * 2);
    const size_t hstep = (size_t)HALF * K * 2;
    const size_t tstep = 2 * hstep;
    const unsigned ldsw = (unsigned)wid * 1024u;
    const int aoff = lds_byte(wr * 64 + fr, fq * 8), boff = lds_byte(wc * 32 + fr, fq * 8);
#define PG8_SA(b, h) (((b) * 2 + (h)) * HTB)
#define PG8_SB(b, h) ((4 + (b) * 2 + (h)) * HTB)
#define PG8_STAGE(bufoff, gbase, voff) do { _Pragma("unroll") for (int _i = 0; _i < 2; ++_i) \
        __builtin_amdgcn_global_load_lds((const unsigned*)((const char*)(gbase) + (voff)[_i]), (PG8_LAS unsigned*)(lds + (bufoff) + ldsw + _i * 8192), 16, 0, 0); } while (0)
#define PG8_LDA(dst, b, h) do { _Pragma("unroll") for (int m = 0; m < 4; ++m) _Pragma("unroll") for (int k = 0; k < 2; ++k) dst[m][k] = *(const PG8_LAS bf16x8*)(lds + PG8_SA(b, h) + aoff + m * 2048 + k * 1024); } while (0)
#define PG8_LDB(dst, b, h) do { _Pragma("unroll") for (int n = 0; n < 2; ++n) _Pragma("unroll") for (int k = 0; k < 2; ++k) dst[n][k] = *(const PG8_LAS bf16x8*)(lds + PG8_SB(b, h) + boff + n * 2048 + k * 1024); } while (0)
#define PG8_MMA(ai, bj, At, Bt) do { __builtin_amdgcn_s_setprio(1); _Pragma("unroll") for (int m = 0; m < 4; ++m) _Pragma("unroll") for (int n = 0; n < 2; ++n) _Pragma("unroll") for (int k = 0; k < 2; ++k) \
        acc[ai][bj][m][n] = __builtin_amdgcn_mfma_f32_16x16x32_bf16(Bt[n][k], At[m][k], acc[ai][bj][m][n], 0, 0, 0); __builtin_amdgcn_s_setprio(0); } while (0)
#define PG8_WAIT_V(n) asm volatile("s_waitcnt vmcnt(" #n ")" ::: "memory")
#define PG8_WAIT_L(n) asm volatile("s_waitcnt lgkmcnt(" #n ")" ::: "memory")
#define PG8_BAR __builtin_amdgcn_s_barrier()
#define PG8_SCHED __builtin_amdgcn_sched_barrier(0)
    Unit cur, nxt; int ui = 0;
    if (!S.next(0, cur)) return;
    f32x4 acc[2][2][4][2];
#pragma unroll
    for (int a = 0; a < 2; ++a)
#pragma unroll
        for (int b = 0; b < 2; ++b)
#pragma unroll
            for (int m = 0; m < 4; ++m)
#pragma unroll
                for (int n = 0; n < 2; ++n) acc[a][b][m][n] = (f32x4){0.f, 0.f, 0.f, 0.f};
    bf16x8 At[4][2], B0[2][2], B1[2][2];
    const char* cA = (const char*)g.A + (size_t)cur.pm * tstep; const char* cB = (const char*)g.Bt + (size_t)cur.pn * tstep;
    S.a_ready(cur);
    if constexpr (SP2) {
        PG8_STAGE(PG8_SB(0, 0), cB, voffB); PG8_STAGE(PG8_SB(0, 1), cB + hstep, voffB); PG8_STAGE(PG8_SA(0, 0), cA, voffA); PG8_STAGE(PG8_SA(0, 1), cA + hstep, voffA);
        if (wr == 1) PG8_BAR;
        PG8_WAIT_V(2); PG8_BAR;
        PG8_STAGE(PG8_SB(1, 0), cB + kstep, voffB); PG8_STAGE(PG8_SA(1, 0), cA + kstep, voffA); PG8_STAGE(PG8_SB(1, 1), cB + hstep + kstep, voffB);
        PG8_WAIT_V(6); PG8_BAR;
    } else {
        PG8_STAGE(PG8_SB(0, 0), cB, voffB); PG8_STAGE(PG8_SA(0, 0), cA, voffA); PG8_STAGE(PG8_SB(0, 1), cB + hstep, voffB); PG8_STAGE(PG8_SA(0, 1), cA + hstep, voffA);
        if (wr == 1) PG8_BAR;
        PG8_WAIT_V(4); PG8_BAR;
        PG8_STAGE(PG8_SB(1, 0), cB + kstep, voffB); PG8_STAGE(PG8_SA(1, 0), cA + kstep, voffA); PG8_STAGE(PG8_SB(1, 1), cB + hstep + kstep, voffB);
        PG8_WAIT_V(6); PG8_BAR;
    }
    for (;;) {
        const bool has_next = S.next(ui + 1, nxt);
        const char* nA = has_next ? (const char*)g.A + (size_t)nxt.pm * tstep : cA; const char* nB = has_next ? (const char*)g.Bt + (size_t)nxt.pn * tstep : cB;
        for (int t = 0; t < nt; t += 2) {
            const bool last = (t == nt - 2);
            const char* a1 = cA + (size_t)(t + 1) * kstep;
            const char* a2 = last ? nA : cA + (size_t)(t + 2) * kstep; const char* b2 = last ? nB : cB + (size_t)(t + 2) * kstep;
            const char* a3 = a2 + kstep; const char* b3 = b2 + kstep;
            if (last && has_next) S.a_ready(nxt);
            if constexpr (SP2) {
            PG8_LDB(B0, 0, 0); PG8_LDB(B1, 0, 1); PG8_SCHED; PG8_LDA(At, 0, 0); PG8_STAGE(PG8_SA(1, 1), a1 + hstep, voffA);
            PG8_WAIT_V(8); PG8_WAIT_L(0); PG8_BAR; PG8_MMA(0, 0, At, B0); PG8_MMA(0, 1, At, B1); PG8_BAR; PG8_SCHED;
            PG8_LDA(At, 0, 1); PG8_STAGE(PG8_SB(0, 0), b2, voffB); PG8_STAGE(PG8_SB(0, 1), b2 + hstep, voffB); PG8_STAGE(PG8_SA(0, 0), a2, voffA);
            PG8_WAIT_V(8); PG8_WAIT_L(0); PG8_BAR; PG8_MMA(1, 0, At, B0); PG8_MMA(1, 1, At, B1); PG8_BAR; PG8_SCHED;
            PG8_LDB(B0, 1, 0); PG8_LDB(B1, 1, 1); PG8_SCHED; PG8_LDA(At, 1, 0); PG8_STAGE(PG8_SA(0, 1), a2 + hstep, voffA);
            PG8_WAIT_V(8); PG8_WAIT_L(0); PG8_BAR; PG8_MMA(0, 0, At, B0); PG8_MMA(0, 1, At, B1); PG8_BAR; PG8_SCHED;
            PG8_LDA(At, 1, 1); PG8_STAGE(PG8_SB(1, 0), b3, voffB); PG8_STAGE(PG8_SB(1, 1), b3 + hstep, voffB); PG8_STAGE(PG8_SA(1, 0), a3, voffA);
            PG8_WAIT_V(8); PG8_WAIT_L(0); PG8_BAR; PG8_MMA(1, 0, At, B0); PG8_MMA(1, 1, At, B1); PG8_BAR; PG8_SCHED;
            } else {
            PG8_LDB(B0, 0, 0); PG8_SCHED; PG8_LDA(At, 0, 0); PG8_STAGE(PG8_SA(1, 1), a1 + hstep, voffA);
            PG8_WAIT_L(8); PG8_BAR; PG8_WAIT_L(0); PG8_MMA(0, 0, At, B0); PG8_BAR; PG8_SCHED;
            PG8_LDB(B1, 0, 1); PG8_STAGE(PG8_SB(0, 0), b2, voffB);
            PG8_BAR; PG8_WAIT_L(0); PG8_MMA(0, 1, At, B1); PG8_BAR;
            PG8_LDA(At, 0, 1); PG8_STAGE(PG8_SA(0, 0), a2, voffA);
            PG8_BAR; PG8_WAIT_L(0); PG8_MMA(1, 0, At, B0); PG8_BAR; PG8_SCHED;
            PG8_STAGE(PG8_SB(0, 1), b2 + hstep, voffB);
            PG8_WAIT_V(6); PG8_BAR; PG8_MMA(1, 1, At, B1); PG8_BAR;
            PG8_LDB(B0, 1, 0); PG8_SCHED; PG8_LDA(At, 1, 0); PG8_STAGE(PG8_SA(0, 1), a2 + hstep, voffA);
            PG8_WAIT_L(8); PG8_BAR; PG8_WAIT_L(0); PG8_MMA(0, 0, At, B0); PG8_BAR; PG8_SCHED;
            PG8_LDB(B1, 1, 1); PG8_STAGE(PG8_SB(1, 0), b3, voffB);
            PG8_BAR; PG8_WAIT_L(0); PG8_MMA(0, 1, At, B1); PG8_BAR;
            PG8_LDA(At, 1, 1); PG8_STAGE(PG8_SA(1, 0), a3, voffA);
            PG8_BAR; PG8_WAIT_L(0); PG8_MMA(1, 0, At, B0); PG8_BAR; PG8_SCHED;
            PG8_STAGE(PG8_SB(1, 1), b3 + hstep, voffB);
            PG8_WAIT_V(6); PG8_BAR; PG8_MMA(1, 1, At, B1); PG8_BAR;
            }
        }
        if constexpr (ALIGN_EPI) { if (wr == 0) PG8_BAR; }
        if constexpr (!Epi::AFTER_DRAIN) { E(acc, cur, wr, wc, fr, fq); S.done(cur); }
        if (!has_next) break;
#pragma unroll
        for (int a = 0; a < 2; ++a)
#pragma unroll
            for (int b = 0; b < 2; ++b)
#pragma unroll
                for (int m = 0; m < 4; ++m)
#pragma unroll
                    for (int n = 0; n < 2; ++n) acc[a][b][m][n] = (f32x4){0.f, 0.f, 0.f, 0.f};
        cur = nxt; cA = nA; cB = nB; ++ui;
        if constexpr (ALIGN_EPI) { if (wr == 1) PG8_BAR; }
    }
    PG8_WAIT_V(0);
    if constexpr (!ALIGN_EPI) { if (wr == 0) PG8_BAR; }
    PG8_BAR;
    if constexpr (Epi::AFTER_DRAIN) { E.fused(acc, cur, wr, wc, fr, fq, lds, wid, lane); S.done(cur); }
#undef PG8_SA
#undef PG8_SB
#undef PG8_STAGE
#undef PG8_LDA
#undef PG8_LDB
#undef PG8_MMA
#undef PG8_WAIT_V
#undef PG8_WAIT_L
#undef PG8_BAR
#undef PG8_SCHED
}
}

#ifndef PG8_SP2
#define PG8_SP2 true
#endif
#ifndef PG8_ALIGN
#define PG8_ALIGN true
#endif
#include <hip/hip_bf16.h>
#include <cmath>
namespace attn_body {
using bf16=__hip_bfloat16;
using bf16x8=__attribute__((ext_vector_type(8)))short;
using s16x4=__attribute__((ext_vector_type(4)))short;
using f32x16=__attribute__((ext_vector_type(16)))float;
using u32x4=__attribute__((ext_vector_type(4)))unsigned;
constexpr int BATCH=2,NHEAD=8,SEQ=8192,D=64,DM=NHEAD*D;
constexpr int NW=8,QBLK=32,QB=QBLK*NW,KVBLK=64,NQB=SEQ/QB;
constexpr int ATTN_PITCH=DM, ATTN_UNIT_ROWS=QB;
__device__ __forceinline__ int crow(int r,int hi){return (r&3)+8*(r>>2)+4*hi;}
#define SBAR() __builtin_amdgcn_sched_barrier(0)
__device__ __forceinline__ void cmask(f32x16&p0,f32x16&p1,int jb,int qrel,int hi){
  const float NEG=-INFINITY; int kb=64*jb+4*hi;
  #pragma unroll
  for(int r=0;r<16;++r){int kv=kb+(r&3)+8*(r>>2); if(kv>qrel)p0[r]=NEG; if(kv+32>qrel)p1[r]=NEG;}
}

constexpr int NSLOT=3, SLOTB=8192;
constexpr int LDS_K=0, LDS_V=NSLOT*SLOTB, LDS_WS=2*NSLOT*SLOTB, LDS_OST=LDS_WS+NW*64*4, LDS_CL=86016, LDS_BYTES=LDS_CL+SEQ*4;
constexpr float C2=0.125f*1.4426950408889634f;
__device__ __forceinline__ void glds16(const void*gsrc,unsigned lds_dst){unsigned keep;
  asm volatile("s_mov_b32 %0, m0\n\ts_mov_b32 m0, %2\n\ts_nop 0\n\tglobal_load_lds_dwordx4 %1, off\n\ts_mov_b32 m0, %0":"=&s"(keep):"v"(gsrc),"s"(lds_dst):"memory");}
__device__ __forceinline__ float max3f(float a,float b,float c){float r;asm("v_max3_f32 %0, %1, %2, %3":"=v"(r):"v"(a),"v"(b),"v"(c));return r;}
__device__ __forceinline__ float max2f(float a,float b){float r;asm("v_max_f32_e32 %0, %1, %2":"=v"(r):"v"(a),"v"(b));return r;}
__device__ __forceinline__ float fadd_s(float a,float b){float r;asm("v_add_f32_e32 %0, %1, %2":"=v"(r):"v"(a),"v"(b));return r;}
__device__ __forceinline__ float fsub_s(float a,float b){float r;asm("v_sub_f32_e32 %0, %1, %2":"=v"(r):"v"(a),"v"(b));return r;}
typedef float f32x2_t __attribute__((ext_vector_type(2))); typedef __bf16 bf16x2_t __attribute__((ext_vector_type(2)));
__device__ __forceinline__ unsigned cvtpk_s(float lo,float hi){f32x2_t v={lo,hi};bf16x2_t b=__builtin_convertvector(v,bf16x2_t);return __builtin_bit_cast(unsigned,b);}
#define WAIT_BAR(N) asm volatile("s_waitcnt vmcnt(" #N ") lgkmcnt(0)\n\ts_barrier":::"memory")

__device__ __forceinline__ void qkt(f32x16&p0,f32x16&p1,const char*Kslot,const bf16x8*qr,int r32,int hi){
  const char*kb=Kslot+hi*1024+r32*16;
  #pragma unroll
  for(int d0=0;d0<4;++d0){
    const bf16x8 b0=*reinterpret_cast<const bf16x8*>(kb+d0*2048);
    const bf16x8 b1=*reinterpret_cast<const bf16x8*>(kb+d0*2048+512);
    p0=__builtin_amdgcn_mfma_f32_32x32x16_bf16(b0,qr[d0],p0,0,0,0);p1=__builtin_amdgcn_mfma_f32_32x32x16_bf16(b1,qr[d0],p1,0,0,0);}
}
typedef __attribute__((address_space(3))) const char* lds_cptr;
typedef short v4i16_t __attribute__((ext_vector_type(4)));
__device__ __forceinline__ void kload8(bf16x8*kf,lds_cptr kp){
  kf[0]=*(const __attribute__((address_space(3))) bf16x8*)(kp);      kf[1]=*(const __attribute__((address_space(3))) bf16x8*)(kp+512);
  kf[2]=*(const __attribute__((address_space(3))) bf16x8*)(kp+2048); kf[3]=*(const __attribute__((address_space(3))) bf16x8*)(kp+2560);
  kf[4]=*(const __attribute__((address_space(3))) bf16x8*)(kp+4096); kf[5]=*(const __attribute__((address_space(3))) bf16x8*)(kp+4608);
  kf[6]=*(const __attribute__((address_space(3))) bf16x8*)(kp+6144); kf[7]=*(const __attribute__((address_space(3))) bf16x8*)(kp+6656);
}
__device__ __forceinline__ void kload2(bf16x8*kf,lds_cptr kp,int j){ kf[2*j]=*(const __attribute__((address_space(3))) bf16x8*)(kp+j*2048); kf[2*j+1]=*(const __attribute__((address_space(3))) bf16x8*)(kp+j*2048+512); }
__device__ __forceinline__ s16x4 vtr(lds_cptr p){ return __builtin_bit_cast(s16x4,__builtin_amdgcn_ds_read_tr16_b64_v4i16((__attribute__((address_space(3))) v4i16_t*)p)); }
__device__ __forceinline__ float rowmax(const f32x16&p0,const f32x16&p1){
  float a=max3f(p0[0],p0[1],p1[0]),b=max3f(p0[2],p0[3],p1[1]);a=max3f(a,p1[2],p1[3]);
  #pragma unroll
  for(int r=4;r<16;r+=4){a=max3f(a,p0[r],p0[r+1]);b=max3f(b,p0[r+2],p0[r+3]);a=max3f(a,p1[r],p1[r+1]);b=max3f(b,p1[r+2],p1[r+3]);}
  const float m=max2f(a,b);
  auto rr=__builtin_amdgcn_permlane32_swap(__float_as_uint(m),__float_as_uint(m),false,false);
  return max2f(__uint_as_float(rr[0]),__uint_as_float(rr[1]));
}
__device__ __forceinline__ void pv(f32x16*o,int vb,bf16x8 pa0,bf16x8 pa1,bf16x8 pa2,bf16x8 pa3){
  #pragma unroll
  for(int d0=0;d0<2;++d0){s16x4 lo[4],hi[4];
    #pragma unroll
    for(int ks=0;ks<4;++ks){
      asm volatile("ds_read_b64_tr_b16 %0,%1 offset:%c2":"=&v"(lo[ks]):"v"(vb),"i"(d0*4096+ks*1024):"memory");
      asm volatile("ds_read_b64_tr_b16 %0,%1 offset:%c2":"=&v"(hi[ks]):"v"(vb),"i"(d0*4096+ks*1024+512):"memory");}
    asm volatile("s_waitcnt lgkmcnt(0)":::"memory");SBAR();
    #define PK(k) (bf16x8){lo[k][0],lo[k][1],lo[k][2],lo[k][3],hi[k][0],hi[k][1],hi[k][2],hi[k][3]}
    o[d0]=__builtin_amdgcn_mfma_f32_32x32x16_bf16(pa0,PK(0),o[d0],0,0,0);
    o[d0]=__builtin_amdgcn_mfma_f32_32x32x16_bf16(pa1,PK(1),o[d0],0,0,0);
    o[d0]=__builtin_amdgcn_mfma_f32_32x32x16_bf16(pa2,PK(2),o[d0],0,0,0);
    o[d0]=__builtin_amdgcn_mfma_f32_32x32x16_bf16(pa3,PK(3),o[d0],0,0,0);
    #undef PK
  }
}

#ifndef ATTN_STORE16
#define ATTN_STORE16(p,v) (*(u32x4*)(p)=(v))
#endif
template<int THRL> __device__ __forceinline__ void attn_unit(int b,int h,int qb,const bf16*Q,const bf16*__restrict__ K,const bf16*__restrict__ V,bf16*O,const float*__restrict__ CLg,const float*__restrict__ GQg,const float*__restrict__ GKg,char*shm){
  int tid=threadIdx.x; asm volatile("":"+v"(tid)); const int lane=tid&63,r32=lane&31,hi=lane>>5; const int wid=__builtin_amdgcn_readfirstlane(tid>>6);
  const long rowbase=(long)b*SEQ; const int q0=qb*QB;
  const bf16*Qw=Q+(rowbase+q0+wid*QBLK)*DM+h*D;
  const lds_cptr shm3=(lds_cptr)shm;
  const unsigned lds0=(unsigned)(uintptr_t)shm;
  float*wsf=(float*)(shm+LDS_WS)+wid*64;
  typedef __attribute__((address_space(3))) float lds_f32; typedef float f32x4_t __attribute__((ext_vector_type(4)));
  lds_f32* const cl3=(lds_f32*)(shm3+LDS_CL);
  bf16x8 qr[4];
  #pragma unroll
  for(int d0=0;d0<4;++d0)qr[d0]=*reinterpret_cast<const bf16x8*>(&Qw[(long)r32*DM+d0*16+hi*8]);
  const float mq0_=GQg[lane],mk0_=GKg[lane];
  { const float*cg=CLg+((long)(b*NHEAD+h))*SEQ;
    const int n_=q0+QB; f32x4_t v_[4]; float run_=0.f;
    if(tid*16<n_){
      #pragma unroll
      for(int j_=0;j_<4;++j_)v_[j_]=*(const f32x4_t*)(cg+tid*16+4*j_);
      #pragma unroll
      for(int j_=0;j_<4;++j_){
        #pragma unroll
        for(int e_=0;e_<4;++e_){run_+=v_[j_][e_];v_[j_][e_]=run_;} } }
    float inc_=run_;
    #pragma unroll
    for(int o_=1;o_<64;o_<<=1){ const float y_=__shfl_up(inc_,o_); if(lane>=o_)inc_+=y_; }
    lds_f32* const wt_=(lds_f32*)(shm3+LDS_WS);
    if(lane==63)wt_[wid]=inc_;
    asm volatile("s_waitcnt vmcnt(0) lgkmcnt(0)\n\ts_barrier":::"memory");
    float off_=inc_-run_;
    for(int w_=0;w_<wid;++w_)off_+=wt_[w_];
    if(tid*16<n_){
      #pragma unroll
      for(int j_=0;j_<4;++j_)*(__attribute__((address_space(3))) f32x4_t*)(cl3+tid*16+4*j_)=(v_[j_]+off_)*1.4426950408889634f; }
    asm volatile("s_waitcnt vmcnt(0) lgkmcnt(0)\n\ts_barrier":::"memory"); }
  int t_start=0; bool chk_=true;
  { float mq=fabsf(mq0_),mk=fabsf(mk0_);
    #pragma unroll
    for(int o_=1;o_<64;o_<<=1){ mq=fmaxf(mq,__shfl_xor(mq,o_)); mk=fmaxf(mk,__shfl_xor(mk,o_)); }
    const float thr=-(40.0f+2.0f*8.0f*1.4426950408889634f*mq*mk), cq0=cl3[q0]; const int kmax=(q0+QB)/KVBLK/2-2; int kk=0;
    #pragma unroll
    for(int st_=32;st_>=1;st_>>=1){ const int c_=kk+st_; if(c_<=kmax){ if(cq0-cl3[128*c_-1]<thr)kk=c_; } }
    t_start=__builtin_amdgcn_readfirstlane(2*kk);
    chk_=__builtin_amdgcn_readfirstlane((int)!(8.0f*1.4426950408889634f*mq*mk*1.01f<(float)THRL-0.5f))!=0; }
  const int NT=(q0+QB)/KVBLK-t_start;
  lds_f32* const cl3t=cl3+t_start*KVBLK;
  const bf16*Kh=K+(rowbase+(long)t_start*KVBLK)*DM+h*D,*Vh=V+(rowbase+(long)t_start*KVBLK)*DM+h*D;
  const float cli=cl3[q0+wid*QBLK+r32];
  const bf16*ksrc=Kh+(long)lane*DM+wid*8;
  const bf16*vsrc=Vh+(long)(16*(wid&3)+(lane>>2))*DM+(wid>>2)*32+(lane&3)*8;
  const unsigned kdst=lds0+LDS_K+wid*1024, vdst=lds0+LDS_V+wid*1024;
  #define DMA_K(t,slot) glds16(ksrc+(long)(t)*KVBLK*DM,(unsigned)__builtin_amdgcn_readfirstlane(kdst+(slot)))
  #define DMA_V(t,slot) glds16(vsrc+(long)(t)*KVBLK*DM,(unsigned)__builtin_amdgcn_readfirstlane(vdst+(slot)))
  const int vb0=(int)(lds0+LDS_V)+((lane>>4)&1)*32+(lane&3)*8+(4*hi+((lane&15)>>2))*64;
  const char*Kbase=shm+LDS_K; bf16x8 kf[8];
  const lds_cptr kp0=shm3+LDS_K+hi*1024+r32*16; const lds_cptr vp0=shm3+LDS_V+((lane>>4)&1)*32+(lane&3)*8+(4*hi+((lane&15)>>2))*64;
  #define BIASFILL(X0,X1,t) do{ const lds_f32* cp_=cl3t+(t)*KVBLK+4*hi; const float bs_=cli-mhat; \
    _Pragma("unroll") for(int g_=0;g_<4;++g_){ const f32x4_t a_=*(const __attribute__((address_space(3))) f32x4_t*)(cp_+8*g_); const f32x4_t b_=*(const __attribute__((address_space(3))) f32x4_t*)(cp_+32+8*g_); \
      _Pragma("unroll") for(int e_=0;e_<4;++e_){ X0[4*g_+e_]=bs_-a_[e_]; X1[4*g_+e_]=bs_-b_[e_]; } } }while(0)
  DMA_K(0,0);DMA_V(0,0);DMA_K(1,SLOTB);
  float mhat=0.f,l_reg=0.f;f32x16 o[2];o[0]=f32x16{};o[1]=f32x16{};
  const int qrel=wid*QBLK+r32;
  #define CMASK(P0,P1,t) do{int jb_=(t)-(NT-4); if(jb_>=0)cmask(P0,P1,jb_,qrel,hi);}while(0)
  bool resc=false;
  #define START(P0,P1) do{ const float rm=rowmax(P0,P1); resc=false; \
    { const float dl=max2f(rm,0.f); mhat=fadd_s(mhat,dl); \
      _Pragma("unroll") for(int r=0;r<16;++r){P0[r]=fsub_s(P0[r],dl);P1[r]=fsub_s(P1[r],dl);} } \
    _Pragma("unroll") for(int r=0;r<16;++r)P0[r]=__builtin_amdgcn_exp2f(P0[r]); }while(0)
  #define RESC() do{ if(resc){ asm volatile("s_waitcnt lgkmcnt(0)":::"memory"); \
      _Pragma("unroll") for(int d_=0;d_<2;++d_) _Pragma("unroll") for(int r=0;r<16;++r)o[d_][r]*=wsf[crow(r,hi)]; } }while(0)
  f32x16 pA0,pA1,pB0,pB1;
  int sl_prev=0,sl_cur=0,sl_next=SLOTB;
  #define ROT() do{sl_prev=sl_cur;sl_cur=sl_next;sl_next=(sl_next==(NSLOT-1)*SLOTB)?0:sl_next+SLOTB;}while(0)
  DMA_K(2,2*SLOTB);
  WAIT_BAR(3);
  BIASFILL(pA0,pA1,0); qkt(pA0,pA1,Kbase,qr,r32,hi);asm volatile("s_nop 15\n\ts_nop 7":"+v"(pA0),"+v"(pA1));CMASK(pA0,pA1,0);
  START(pA0,pA1);
  _Pragma("unroll") for(int r=0;r<16;++r)pA1[r]=__builtin_amdgcn_exp2f(pA1[r]);
  BIASFILL(pB0,pB1,1);
  WAIT_BAR(0);
  DMA_K(3,0);DMA_V(1,SLOTB);
  ROT();
  kload8(kf,kp0+sl_cur);
  WAIT_BAR(2);
  s16x4 vlo[8],vhi[8]; u32x4 pw0,pw1,pw2,pw3;
  #define PKW(P,B) cvtpk_s(P[B],P[B+1])
  #define PAF(k) __builtin_bit_cast(bf16x8,pw##k)
  #define VFR(i) (bf16x8){vlo[i][0],vlo[i][1],vlo[i][2],vlo[i][3],vhi[i][0],vhi[i][1],vhi[i][2],vhi[i][3]}
  #define PIN(x) asm volatile("":"+v"(x))
  #define MX3(a,b,c) __builtin_fmaxf(__builtin_fmaxf((a),(b)),(c))
  #define GAPA(MF,A0,A1,A2,A3,W0,W1,PW) do{ MF; sacc+=A0; sacc+=A1; sacc+=A2; sacc+=A3; PIN(sacc); W0; W1; PIN(PW); SBAR(); }while(0)
  #define EX(v) __builtin_amdgcn_exp2f(v)
  #define GAPB(MF,X,B,GF_,Y,OFF) do{ MF; f32x4_t bl_; if(GF_){ bl_=*(const __attribute__((address_space(3))) f32x4_t*)(bcp_+(OFF)); } \
    X[B]=EX(X[B]); X[B+1]=EX(X[B+1]); X[B+2]=EX(X[B+2]); X[B+3]=EX(X[B+3]); PIN(X); \
    if(GF_){ Y[B]=bbs_-bl_[0]; Y[B+1]=bbs_-bl_[1]; Y[B+2]=bbs_-bl_[2]; Y[B+3]=bbs_-bl_[3]; PIN(Y); } SBAR(); }while(0)
  #define VRD(i) do{ vlo[i]=vtr(vp_+(((i)>>2)*4096+((i)&3)*1024)); vhi[i]=vtr(vp_+(((i)>>2)*4096+((i)&3)*1024+512)); }while(0)
  #define KRD(G,j) do{ if(G){ kload2(kf,kp0+sl_next,j); SBAR(); } }while(0)
  #define STEP(C0,C1,P0,P1,t,GK,GV,GL,GF) do{ SBAR(); \
    const lds_cptr vp_=vp0+sl_prev; \
    VRD(0); SBAR(); float sacc=(P0[0]+P0[1]); \
    GAPA(C0=__builtin_amdgcn_mfma_f32_32x32x16_bf16(kf[0],qr[0],C0,0,0,0), P0[2],P0[3],P0[4],P0[5],     pw0[0]=PKW(P0,0), pw0[1]=PKW(P0,2), pw0); \
    VRD(4); SBAR(); GAPA(C1=__builtin_amdgcn_mfma_f32_32x32x16_bf16(kf[1],qr[0],C1,0,0,0), P0[6],P0[7],P0[8],P0[9],     pw0[2]=PKW(P0,4), pw0[3]=PKW(P0,6), pw0); \
    VRD(1); SBAR(); GAPA(C0=__builtin_amdgcn_mfma_f32_32x32x16_bf16(kf[2],qr[1],C0,0,0,0),   P0[10],P0[11],P0[12],P0[13], pw1[0]=PKW(P0,8), pw1[1]=PKW(P0,10), pw1); \
    VRD(5); SBAR(); GAPA(C1=__builtin_amdgcn_mfma_f32_32x32x16_bf16(kf[3],qr[1],C1,0,0,0),   P0[14],P0[15],P1[0],P1[1],   pw1[2]=PKW(P0,12),pw1[3]=PKW(P0,14), pw1); \
    VRD(2); SBAR(); GAPA(C0=__builtin_amdgcn_mfma_f32_32x32x16_bf16(kf[4],qr[2],C0,0,0,0),   P1[2],P1[3],P1[4],P1[5],     pw2[0]=PKW(P1,0), pw2[1]=PKW(P1,2), pw2); \
    VRD(6); SBAR(); GAPA(C1=__builtin_amdgcn_mfma_f32_32x32x16_bf16(kf[5],qr[2],C1,0,0,0),   P1[6],P1[7],P1[8],P1[9],     pw2[2]=PKW(P1,4), pw2[3]=PKW(P1,6), pw2); \
    VRD(3); SBAR(); GAPA(C0=__builtin_amdgcn_mfma_f32_32x32x16_bf16(kf[6],qr[3],C0,0,0,0),   P1[10],P1[11],P1[12],P1[13], pw3[0]=PKW(P1,8), pw3[1]=PKW(P1,10), pw3); \
    VRD(7); SBAR(); GAPA(C1=__builtin_amdgcn_mfma_f32_32x32x16_bf16(kf[7],qr[3],C1,0,0,0),   P1[14],P1[15],0.f,0.f,       pw3[2]=PKW(P1,12),pw3[3]=PKW(P1,14), pw3); \
    l_reg+=sacc; \
    if(GK){DMA_K((t)+3,sl_cur);} if(GV){DMA_V((t)+1,sl_next);} \
    CMASK(C0,C1,t); \
    resc=false; \
    if(chk_){ float a=MX3(C0[0],C0[1],C1[0]),b=MX3(C0[2],C0[3],C1[1]); a=MX3(a,C1[2],C1[3]); \
      _Pragma("unroll") for(int r=4;r<16;r+=4){a=MX3(a,C0[r],C0[r+1]);b=MX3(b,C0[r+2],C0[r+3]);a=MX3(a,C1[r],C1[r+1]);b=MX3(b,C1[r+2],C1[r+3]);} \
      float rm=__builtin_fmaxf(a,b); { auto rr=__builtin_amdgcn_permlane32_swap(__float_as_uint(rm),__float_as_uint(rm),false,false); rm=__builtin_fmaxf(__uint_as_float(rr[0]),__uint_as_float(rr[1])); } \
      if(__builtin_expect(__any(rm>(float)THRL),0)){ const float dl=__builtin_fmaxf(rm,0.f); mhat+=dl; \
        _Pragma("unroll") for(int r=0;r<16;++r){C0[r]-=dl;C1[r]-=dl;} \
        const float f=__builtin_amdgcn_exp2f(-dl); l_reg*=f; if(hi==0)wsf[r32]=f; resc=true; } } \
    const lds_f32* const bcp_=cl3t+((t)+1)*KVBLK+4*hi; const float bbs_=cli-mhat; \
    SBAR(); \
    GAPB(o[0]=__builtin_amdgcn_mfma_f32_32x32x16_bf16(PAF(0),VFR(0),o[0],0,0,0), C0,0, GF,P0,0); \
    GAPB(o[1]=__builtin_amdgcn_mfma_f32_32x32x16_bf16(PAF(0),VFR(4),o[1],0,0,0), C0,4, GF,P0,8); \
    KRD(GL,0); GAPB(o[0]=__builtin_amdgcn_mfma_f32_32x32x16_bf16(PAF(1),VFR(1),o[0],0,0,0), C0,8, GF,P0,16); \
    KRD(GL,1); GAPB(o[1]=__builtin_amdgcn_mfma_f32_32x32x16_bf16(PAF(1),VFR(5),o[1],0,0,0), C0,12, GF,P0,24); \
    KRD(GL,2); GAPB(o[0]=__builtin_amdgcn_mfma_f32_32x32x16_bf16(PAF(2),VFR(2),o[0],0,0,0), C1,0, GF,P1,32); \
    KRD(GL,3); GAPB(o[1]=__builtin_amdgcn_mfma_f32_32x32x16_bf16(PAF(2),VFR(6),o[1],0,0,0), C1,4, GF,P1,40); \
    GAPB(o[0]=__builtin_amdgcn_mfma_f32_32x32x16_bf16(PAF(3),VFR(3),o[0],0,0,0), C1,8, GF,P1,48); \
    GAPB(o[1]=__builtin_amdgcn_mfma_f32_32x32x16_bf16(PAF(3),VFR(7),o[1],0,0,0), C1,12, GF,P1,56); \
    }while(0)
  int t=1;
  #undef CMASK
  #define CMASK(P0,P1,t) do{}while(0)
  for(;t+5<NT;t+=2){
    STEP(pB0,pB1,pA0,pA1,t,true,true,true,true);     WAIT_BAR(2); RESC(); ROT();
    STEP(pA0,pA1,pB0,pB1,t+1,true,true,true,true);   WAIT_BAR(2); RESC(); ROT();
  }
  #undef CMASK
  #define CMASK(P0,P1,t) do{int jb_=(t)-(NT-4); if(jb_>=0)cmask(P0,P1,jb_,qrel,hi);}while(0)
  #define ENDW(tt) do{ if((tt)+3<NT){WAIT_BAR(2);} else if((tt)+2<NT){WAIT_BAR(1);} else {WAIT_BAR(0);} }while(0)
  for(;t+1<NT;t+=2){
    STEP(pB0,pB1,pA0,pA1,t,(t+3<NT),(t+1<NT),(t+1<NT),true);       ENDW(t);   RESC(); ROT();
    STEP(pA0,pA1,pB0,pB1,t+1,(t+4<NT),(t+2<NT),(t+2<NT),true);     ENDW(t+1); RESC(); ROT();
  }
  STEP(pB0,pB1,pA0,pA1,NT-1,false,false,false,false); RESC();
  { float sacc=pB0[0]+pB0[1]; _Pragma("unroll") for(int r=2;r<16;++r)sacc+=pB0[r]; _Pragma("unroll") for(int r=0;r<16;++r)sacc+=pB1[r]; l_reg+=sacc;
    pw0=(u32x4){PKW(pB0,0),PKW(pB0,2),PKW(pB0,4),PKW(pB0,6)};pw1=(u32x4){PKW(pB0,8),PKW(pB0,10),PKW(pB0,12),PKW(pB0,14)};pw2=(u32x4){PKW(pB1,0),PKW(pB1,2),PKW(pB1,4),PKW(pB1,6)};pw3=(u32x4){PKW(pB1,8),PKW(pB1,10),PKW(pB1,12),PKW(pB1,14)};
    SBAR(); pv(o,vb0+sl_cur,PAF(0),PAF(1),PAF(2),PAF(3)); }
  #undef PKW
  #undef PAF
  #undef VFR
  #undef PIN
  #undef MX3
  #undef GAPA
  #undef GAPB
  #undef EX
  #undef VRD
  #undef KRD
  #undef STEP
  #undef ENDW
  {auto rr=__builtin_amdgcn_permlane32_swap(__float_as_uint(l_reg),__float_as_uint(l_reg),false,false);l_reg=__uint_as_float(rr[0])+__uint_as_float(rr[1]);}
  if(hi==0)wsf[32+r32]=l_reg;asm volatile("s_waitcnt lgkmcnt(0)":::"memory");
  float rli[16];
  #pragma unroll
  for(int r=0;r<16;++r)rli[r]=__builtin_amdgcn_rcpf(wsf[32+crow(r,hi)]);
  bf16*Ow=O+(rowbase+q0+wid*QBLK)*DM+h*D;
  { bf16*stg=(bf16*)(shm+LDS_OST)+wid*2048;
    #pragma unroll
    for(int r=0;r<16;++r){const int orow=crow(r,hi);
      #pragma unroll
      for(int d0=0;d0<2;++d0)stg[orow*64+d0*32+r32]=__float2bfloat16(o[d0][r]*rli[r]);}
    asm volatile("s_waitcnt lgkmcnt(0)":::"memory");
    #pragma unroll
    for(int i=0;i<4;++i){const int row=i*8+(lane>>3),ch=lane&7; const u32x4 v=*(const u32x4*)(stg+row*64+ch*8); ATTN_STORE16(Ow+(long)row*DM+ch*8,v);} }
  asm volatile("s_waitcnt lgkmcnt(0)\n\ts_barrier":::"memory");
  #undef DMA_K
  #undef DMA_V
  #undef CMASK
  #undef START
  #undef RESC
  #undef ROT
  #undef BIASFILL
}
constexpr int ATTN_LDS_BYTES=LDS_BYTES;
struct AttnTensors { const bf16* Q; const bf16* K; const bf16* V; bf16* O; const float* CL; const float* GQ; const float* GK; };
struct AttnUnit { int bh; int qb; };
struct StaticOrder {
  int vcu,G;
  __device__ __forceinline__ explicit StaticOrder(int grid,int block):vcu((grid%8==0)?(block%8)*(grid/8)+block/8:block),G(grid){}
  __device__ __forceinline__ bool next(int i,AttnUnit&u)const{ const int p=vcu+G*(i>>1); if(p>=BATCH*NHEAD*NQB/2)return false; const int s=p&15; u.bh=p>>4; u.qb=(i&1)?31-s:s; return true; }
  __device__ __forceinline__ void a_ready(const AttnUnit&)const{}
  __device__ __forceinline__ void done(const AttnUnit&)const{}
};
template<class Sched,int THRL=16> __device__ __forceinline__ void attn_phase(char*lds,const AttnTensors&T,const Sched&S){
  AttnUnit u;
  for(int i=0;S.next(i,u);++i){ S.a_ready(u); attn_unit<THRL>(u.bh/NHEAD,u.bh%NHEAD,u.qb,T.Q,T.K,T.V,T.O,T.CL,T.GQ,T.GK,lds); S.done(u); }
}
template<int THRL=16> __device__ __forceinline__ void attn_phase_dyn(char*lds,const AttnTensors&T,unsigned*cnt,volatile __attribute__((address_space(3))) int*word,int myq){
  for(;;){
    if(threadIdx.x==0){ int got=-1;
      for(int k=0;k<8&&got<0;++k){ const int q=(myq+k)&7; const unsigned idx=__hip_atomic_fetch_add(cnt+64*q,1u,__ATOMIC_RELAXED,__HIP_MEMORY_SCOPE_AGENT); if(idx<64u)got=q*64+(int)idx; }
      *word=got; }
    __syncthreads();
    const int j=__builtin_amdgcn_readfirstlane(*word);
    if(j<0)break;
    const int q=j>>6,k=j&63,bh=2*q+(k&1),qb=31-(k>>1);
    attn_unit<THRL>(bh/NHEAD,bh%NHEAD,qb,T.Q,T.K,T.V,T.O,T.CL,T.GQ,T.GK,lds);
  }
  __syncthreads();
}
#undef SBAR
#undef WAIT_BAR
}
#include <hip/hip_cooperative_groups.h>
namespace cg = cooperative_groups;
constexpr int NWAVES = 8;
#ifndef REP_P0
#define REP_P0 1
#endif
#ifndef REP_T
#define REP_T 1
#endif
#ifndef REP_P1
#define REP_P1 1
#endif
#ifndef REP_ATT
#define REP_ATT 1
#endif
#ifndef REP_GATES
#define REP_GATES 1
#endif
#ifndef REP_P7F
#define REP_P7F 1
#endif
#ifndef REP_I3
#define REP_I3 1
#endif
#ifndef REP_P5
#define REP_P5 1
#endif
#ifndef PG8_ALIGN1
#define PG8_ALIGN1 PG8_ALIGN
#endif
#ifndef GATE_TAKE
#define GATE_TAKE 2
#endif
#ifndef REP_P6
#define REP_P6 1
#endif
constexpr int BATCH = 2, T = 8192, D = 1024, M = BATCH * T, DEPTH = 2;
constexpr int CC = 512, CW = 31, NH = 8, FF = 2816, INC = 4616, NIN = 19 * 256;
constexpr size_t MiB = 1u << 20;
constexpr size_t W_STRIDE = 32 * MiB, W_IN = 0, W_C = 10 * MiB, W_A = 11 * MiB, W_O = 12 * MiB, W_F = 14 * MiB, W_D = 26 * MiB;
constexpr size_t WS_XB = 64 * MiB, WS_GA = 96 * MiB, WS_GB = 128 * MiB, WS_Q = 160 * MiB, WS_K = 176 * MiB, WS_V = 192 * MiB, WS_G = 208 * MiB, WS_AC = 224 * MiB,
                 WS_SS = 240 * MiB, WS_LF = 241 * MiB, WS_CL = 242 * MiB, WS_CTL = 243 * MiB, WS_END = 244 * MiB;
constexpr size_t WS_HB = 96 * MiB;
static_assert(WS_HB + (size_t)M * FF * 2 <= WS_V && W_F + (size_t)2 * FF * D * 2 <= W_D && W_D + (size_t)D * FF * 2 <= W_STRIDE && (size_t)NIN * D * 2 <= W_C, "d_ws map");
constexpr int RING_BYTES = 131072, LDS_BYTES = 135168, LDS_BARST = RING_BYTES + 64;
constexpr size_t CTL_ZERO_BYTES = 65536;

#define LAS __attribute__((address_space(3)))
typedef unsigned short bf16;
typedef unsigned v4u __attribute__((ext_vector_type(4)));
typedef float f32x4 __attribute__((ext_vector_type(4)));
typedef float f32x2 __attribute__((ext_vector_type(2)));
#define LDS_WAIT() asm volatile("s_waitcnt lgkmcnt(0)" ::: "memory")
__device__ __forceinline__ unsigned f2bf(float f) { unsigned u = __builtin_bit_cast(unsigned, f); return (u + 0x7fffu + ((u >> 16) & 1u)) >> 16; }
__device__ __forceinline__ unsigned pk2(float lo, float hi) { return f2bf(lo) | (f2bf(hi) << 16); }
__device__ __forceinline__ float wave_sum(float v) {
#pragma unroll
    for (int o = 1; o < 64; o <<= 1) v += __shfl_xor(v, o);
    return v;
}
__device__ __forceinline__ void tr_item(const float* W, int ldw, int K, bf16* WT, int kb, int orow0, int src0, int valid, const float* gk, LAS float* scr, int lane) {
    const int k0 = 64 * kb, c = lane & 31;
    float v[32], gsc[32];
    const bool ok = c < valid;
#pragma unroll
    for (int i = 0; i < 32; ++i) { const int kk = 2 * i + (lane >> 5); v[i] = ok ? W[(size_t)(k0 + kk) * ldw + src0 + c] : 0.f; gsc[i] = gk ? gk[k0 + kk] : 1.0f; }
#pragma unroll
    for (int i = 0; i < 32; ++i) { const int kk = 2 * i + (lane >> 5); scr[kk * 33 + c] = v[i] * gsc[i]; }
    LDS_WAIT(); asm volatile("" ::: "memory");
    const int ch = lane & 7;
#pragma unroll
    for (int j = 0; j < 4; ++j) { const int n = (lane >> 3) + 8 * j; const LAS float* s = scr + (8 * ch) * 33 + n;
        v4u o; o.x = pk2(s[0 * 33], s[1 * 33]); o.y = pk2(s[2 * 33], s[3 * 33]); o.z = pk2(s[4 * 33], s[5 * 33]); o.w = pk2(s[6 * 33], s[7 * 33]);
        *(v4u*)(WT + (size_t)(orow0 + n) * K + k0 + 8 * ch) = o; }
    LDS_WAIT(); asm volatile("" ::: "memory");
}
__device__ __forceinline__ int src_in(int ob, int& valid) {
    const int p = ob >> 3, sub = ob & 7; valid = 32;
    if (p < 4) return sub < 4 ? 128 * p + 32 * sub : 512 + 128 * p + 32 * (sub - 4);
    if (p < 8) { const int base = p < 6 ? 1024 : 1536, hh = 4 * (p & 1) + (sub & 3), bj = sub >> 2; return base + hh * 64 + 32 * bj; }
    if (p < 10) return 2048 + 256 * (p - 8) + 32 * sub;
    if (p == 10) { if (sub == 0) { valid = 8; return 2560; } valid = 0; return 0; }
    if (p < 15) return 2568 + 256 * (p - 11) + 32 * sub;
    return 3592 + 256 * (p - 15) + 32 * sub;
}
__device__ __forceinline__ int src_ffn(int ob) { const int p = ob >> 3, sub = ob & 7; return sub < 4 ? 128 * p + 32 * sub : FF + 128 * p + 32 * (sub - 4); }

#define XB_TMO      128
#define XB_XCNT(j)  (256  + 64 * (j))
#define XB_XSUB(j)  (1280 + 64 * (j))
#define XB_XGEN(j)  (2304 + 64 * (j))
#define XB_TOP      3328
#define XB_TOPGEN   3392
#define XCD_BAR_WORDS 3456
#define XB_SPIN_CAP (1u << 18)

__device__ __forceinline__ unsigned xb_ld(unsigned* p)              { return __hip_atomic_load(p, __ATOMIC_RELAXED, __HIP_MEMORY_SCOPE_AGENT); }
__device__ __forceinline__ unsigned xb_add(unsigned* p, unsigned v) { return __hip_atomic_fetch_add(p, v, __ATOMIC_RELAXED, __HIP_MEMORY_SCOPE_AGENT); }
__device__ __forceinline__ unsigned xb_xcc_id() { return (unsigned)__builtin_amdgcn_s_getreg((3 << 11) | 20) & 0xFu; }
#define XB_SPIN(cond, bar) do { unsigned _sp = 0; while (cond) { __builtin_amdgcn_s_sleep(1); \
    if ((++_sp & 255u) == 0u) { if (xb_ld(&(bar)[XB_TMO])) break; if (_sp > XB_SPIN_CAP) { atomicAdd(&(bar)[XB_TMO], 1u); break; } } } } while (0)

struct XcdBarrier {
    unsigned* bar; unsigned x;
    volatile LAS unsigned* st;
};

__device__ __forceinline__ XcdBarrier xcd_barrier_post(unsigned* bar, volatile LAS unsigned* st) {
    XcdBarrier b; b.bar = bar; b.x = xb_xcc_id(); b.st = st;
    if (threadIdx.x == 0) (void)xb_add(&bar[XB_XCNT(b.x)], 1u);
    return b;
}
__device__ __forceinline__ void xcd_barrier_complete(unsigned* bar, unsigned x, unsigned& nloc, unsigned& nx) {
    const unsigned G = gridDim.x * gridDim.y * gridDim.z;
    unsigned sum, cnt, mine, sp = 0u;
    for (;;) {
        sum = 0u; cnt = 0u; mine = 0u;
#pragma unroll
        for (unsigned j = 0; j < 16; ++j) { const unsigned c = xb_ld(&bar[XB_XCNT(j)]); sum += c; cnt += (c > 0u) ? 1u : 0u; mine = (j == x) ? c : mine; }
        if (sum == G) break;
        __builtin_amdgcn_s_sleep(1);
        if ((++sp & 255u) == 0u) { if (xb_ld(&bar[XB_TMO])) break; if (sp > XB_SPIN_CAP) { atomicAdd(&bar[XB_TMO], 1u); break; } }
    }
    nloc = mine > 0u ? mine : 1u; nx = cnt > 0u ? cnt : 1u;
}

__device__ __forceinline__ void xcd_barrier(const XcdBarrier& b) {
    asm volatile("s_waitcnt vmcnt(0)" ::: "memory");
    __syncthreads();
    if (threadIdx.x == 0) {
        unsigned* bar = b.bar;
        __builtin_amdgcn_s_waitcnt(0);
        unsigned nloc = b.st[0], nx = b.st[1];
        if (nloc == 0u) { xcd_barrier_complete(bar, b.x, nloc, nx); b.st[0] = nloc; b.st[1] = nx; }
        const unsigned old = xb_add(&bar[XB_XSUB(b.x)], 1u);
        const unsigned gen = old / nloc;
        if (old + 1u == (gen + 1u) * nloc) {
            __builtin_amdgcn_fence(__ATOMIC_RELEASE, "agent");
            asm volatile("s_waitcnt vmcnt(0)" ::: "memory");
            const unsigned og = xb_add(&bar[XB_TOP], 1u);
            const unsigned tg = og / nx;
            if (og + 1u == (tg + 1u) * nx) xb_add(&bar[XB_TOPGEN], 1u);
            else XB_SPIN(xb_ld(&bar[XB_TOPGEN]) == tg, bar);
            __builtin_amdgcn_fence(__ATOMIC_ACQUIRE, "agent");
            xb_add(&bar[XB_XGEN(b.x)], 1u);
            asm volatile("s_waitcnt vmcnt(0)" ::: "memory");
        } else {
            XB_SPIN(xb_ld(&bar[XB_XGEN(b.x)]) == gen, bar);
            __builtin_amdgcn_fence(__ATOMIC_ACQUIRE, "agent");
            asm volatile("s_waitcnt vmcnt(0)" ::: "memory");
        }
    }
    __syncthreads();
}

struct Args { const float* in[16]; float* out; unsigned char* ws; };

__device__ __forceinline__ void scan_seq(LAS unsigned char* lds, int tid, const float* lf, float* cl) {
    const int lane = tid & 63, wave = tid >> 6;
    f32x4 v[4];
#pragma unroll
    for (int j = 0; j < 4; ++j) v[j] = *(const f32x4*)(lf + tid * 16 + 4 * j);
    float run = 0.f;
#pragma unroll
    for (int j = 0; j < 4; ++j)
#pragma unroll
        for (int e = 0; e < 4; ++e) { run += v[j][e]; v[j][e] = run; }
    float inc = run;
#pragma unroll
    for (int o = 1; o < 64; o <<= 1) { const float y = __shfl_up(inc, o); if (lane >= o) inc += y; }
    LAS float* wt = (LAS float*)lds;
    if (lane == 63) wt[wave] = inc;
    __syncthreads();
    float off = inc - run;
    for (int w = 0; w < wave; ++w) off += wt[w];
#pragma unroll
    for (int j = 0; j < 4; ++j) { *(f32x4*)(cl + tid * 16 + 4 * j) = (v[j] + off) * 1.4426950408889634f; }
    __syncthreads();
}

#define XB_LSUB(j)  (3584 + 64 * (j))
#define XB_LGEN(j)  (4608 + 64 * (j))
#define XB_RMAXA(r) (5696 + 64 * (r))
#define XB_RMAXB(r) (6208 + 64 * (r))
__device__ __forceinline__ void xcd_local_barrier(const XcdBarrier& b, unsigned nloc) {
    asm volatile("s_waitcnt vmcnt(0)" ::: "memory");
    __syncthreads();
    if (threadIdx.x == 0) {
        unsigned* bar = b.bar;
        const unsigned old = xb_add(&bar[XB_LSUB(b.x)], 1u);
        const unsigned gen = old / nloc;
        if (old + 1u == (gen + 1u) * nloc) xb_add(&bar[XB_LGEN(b.x)], 1u);
        else XB_SPIN(xb_ld(&bar[XB_LGEN(b.x)]) == gen, bar);
        __builtin_amdgcn_fence(__ATOMIC_ACQUIRE, "agent");
        asm volatile("s_waitcnt vmcnt(0)" ::: "memory");
    }
    __syncthreads();
}
struct OneUnit { int q, k0, n;
    __device__ __forceinline__ bool next(int i, pg8::Unit& u) const { if (i >= n) return false; const int k = k0 + i; u.pm = 8 * q + (k & 7); u.pn = k >> 3; return true; }
    __device__ __forceinline__ void a_ready(const pg8::Unit&) const {}
    __device__ __forceinline__ void done(const pg8::Unit&) const {} };
__device__ __forceinline__ int claim_unit(unsigned* cnt, int myq, int per_q, volatile LAS int* word, unsigned take = 1u) {
    if (threadIdx.x == 0) { int got = -1;
        for (int k = 0; k < 8 && got < 0; ++k) { const int q = (myq + k) & 7; const unsigned idx = __hip_atomic_fetch_add(cnt + 64 * q, take, __ATOMIC_RELAXED, __HIP_MEMORY_SCOPE_AGENT); if (idx < (unsigned)per_q) got = q * per_q + (int)idx; }
        *word = got; }
    __syncthreads();
    const int j = __builtin_amdgcn_readfirstlane(*word);
    __syncthreads();
    return j;
}
__device__ __forceinline__ void conv_phase(LAS unsigned char* lds, unsigned* cnt, int myq, volatile LAS int* word, int tid, const bf16* Gin, const float* wdw, const float* bdw, const float* gln, const float* bln, bf16* AC) {
    LAS unsigned* lin = (LAS unsigned*)lds;
    LAS float* lout = (LAS float*)(lds + 63488);
    const int lane = tid & 63, wave = tid >> 6, cp = tid & 255, th = tid >> 8;
    f32x2 wv[31];
#pragma unroll
    for (int k = 0; k < 31; ++k) wv[k] = *(const f32x2*)(wdw + k * 512 + 2 * cp);
    const f32x2 bb = *(const f32x2*)(bdw + 2 * cp);
    const f32x4 g0 = *(const f32x4*)(gln + 8 * lane), g1 = *(const f32x4*)(gln + 8 * lane + 4), b0 = *(const f32x4*)(bln + 8 * lane), b1 = *(const f32x4*)(bln + 8 * lane + 4);
    for (;;) {
        const int pass = claim_unit(cnt, myq, (M / 32) / 8, word); if (pass < 0) break;
        const int m0 = pass * 32, tb = m0 & (T - 1);
        for (int c = tid; c < 62 * 64; c += NWAVES * 64) { const int r = c >> 6, ch = c & 63; v4u v = (v4u){0u, 0u, 0u, 0u};
            if (tb - 30 + r >= 0) v = *(const v4u*)(Gin + (size_t)(m0 - 30 + r) * 512 + ch * 8);
            *(LAS v4u*)(lin + r * 256 + ch * 4) = v; }
        __syncthreads();
        f32x2 av[16];
#pragma unroll
        for (int o = 0; o < 16; ++o) av[o] = bb;
#pragma unroll
        for (int r = 0; r < 46; ++r) { const unsigned v = lin[(16 * th + r) * 256 + cp]; const f32x2 xv = (f32x2){__uint_as_float(v << 16), __uint_as_float(v & 0xffff0000u)};
#pragma unroll
            for (int o = 0; o < 16; ++o) { const int k = r - o; if (k >= 0 && k < 31) av[o] = __builtin_elementwise_fma(wv[k], xv, av[o]); } }
#pragma unroll
        for (int o = 0; o < 16; ++o) *(LAS f32x2*)(lout + (16 * th + o) * 512 + 2 * cp) = av[o];
        __syncthreads();
#pragma unroll
        for (int i = 0; i < 4; ++i) { const int tok = 4 * wave + i;
            f32x4 x0 = *(const LAS f32x4*)(lout + tok * 512 + 8 * lane), x1 = *(const LAS f32x4*)(lout + tok * 512 + 8 * lane + 4);
            const float mean = wave_sum(((x0[0] + x0[1]) + (x0[2] + x0[3])) + ((x1[0] + x1[1]) + (x1[2] + x1[3]))) * (1.0f / 512.0f);
            x0 = x0 - mean; x1 = x1 - mean;
            const float var = wave_sum(((x0[0] * x0[0] + x0[1] * x0[1]) + (x0[2] * x0[2] + x0[3] * x0[3])) + ((x1[0] * x1[0] + x1[1] * x1[1]) + (x1[2] * x1[2] + x1[3] * x1[3]))) * (1.0f / 512.0f);
            const float rstd = __builtin_amdgcn_rsqf(var + 1e-6f);
            x0 = x0 * rstd * g0 + b0; x1 = x1 * rstd * g1 + b1;
#pragma unroll
            for (int e = 0; e < 4; ++e) { x0[e] = x0[e] * pg8::sigm(x0[e]); x1[e] = x1[e] * pg8::sigm(x1[e]); }
            *(pg8::u32x4*)(AC + (size_t)(m0 + tok) * 512 + 8 * lane) = pg8::pack8(x0, x1); }
        __syncthreads();
    }
}
constexpr int I_IN = (D / 64) * (NIN / 32), I_C = (CC / 64) * (D / 32), I_O = (D / 64) * (D / 32), I_F = (D / 64) * (2 * FF / 32), I_D = (FF / 64) * (D / 32);
constexpr int I_L = I_IN + 2 * I_C + I_O + I_F + I_D, W_ITEMS = I_L;
__device__ __forceinline__ void weight_item(const Args& args, unsigned char* ws, int it, LAS float* scr, int lane) {
            const int l = it / I_L; int r = it % I_L; unsigned char* wl = ws + (size_t)l * W_STRIDE;
            if (r < I_IN) { const int nblk = NIN / 32, kb = r / nblk, ob = r % nblk; int valid; const int s0 = src_in(ob, valid);
                tr_item(args.in[2] + (size_t)l * D * INC, INC, D, (bf16*)(wl + W_IN), kb, 32 * ob, s0, valid, args.in[1] + l * D, scr, lane); return; } r -= I_IN;
            if (r < I_C) { const int nblk = D / 32, kb = r / nblk, ob = r % nblk;
                tr_item(args.in[8] + (size_t)l * CC * D, D, CC, (bf16*)(wl + W_C), kb, 32 * ob, 32 * ob, 32, nullptr, scr, lane); return; } r -= I_C;
            if (r < I_C) { const int nblk = D / 32, kb = r / nblk, ob = r % nblk;
                tr_item(args.in[11] + (size_t)l * CC * D, D, CC, (bf16*)(wl + W_A), kb, 32 * ob, 32 * ob, 32, nullptr, scr, lane); return; } r -= I_C;
            if (r < I_O) { const int nblk = D / 32, kb = r / nblk, ob = r % nblk;
                tr_item(args.in[12] + (size_t)l * D * D, D, D, (bf16*)(wl + W_O), kb, 32 * ob, 32 * ob, 32, nullptr, scr, lane); return; } r -= I_O;
            if (r < I_F) { const int nblk = 2 * FF / 32, kb = r / nblk, ob = r % nblk;
                tr_item(args.in[14] + (size_t)l * D * 2 * FF, 2 * FF, D, (bf16*)(wl + W_F), kb, 32 * ob, src_ffn(ob), 32, args.in[13] + l * D, scr, lane); return; } r -= I_F;
            { const int nblk = D / 32, kb = r / nblk, ob = r % nblk;
                tr_item(args.in[15] + (size_t)l * FF * D, D, FF, (bf16*)(wl + W_D), kb, 32 * ob, 32 * ob, 32, nullptr, scr, lane); }
}

__global__ void __launch_bounds__(NWAVES * 64, 2) fwd_kernel(Args args) {
    extern __shared__ __attribute__((aligned(16))) unsigned char lds_raw[];
    cg::grid_group grid = cg::this_grid();
    LAS unsigned char* lds = (LAS unsigned char*)lds_raw;
    if (threadIdx.x < 2) ((volatile LAS unsigned*)(lds + LDS_BARST))[threadIdx.x] = 0u;
    __syncthreads();
    const XcdBarrier bar = xcd_barrier_post((unsigned*)(args.ws + WS_CTL), (volatile LAS unsigned*)(lds + LDS_BARST));
    if (threadIdx.x == 0) { unsigned* cw = (unsigned*)(args.ws + WS_CTL); __hip_atomic_fetch_max(cw + XB_RMAXA(blockIdx.x & 7u), bar.x + 1u, __ATOMIC_RELAXED, __HIP_MEMORY_SCOPE_AGENT); __hip_atomic_fetch_max(cw + XB_RMAXB(blockIdx.x & 7u), 16u - bar.x, __ATOMIC_RELAXED, __HIP_MEMORY_SCOPE_AGENT); }
    if (args.ws == nullptr) grid.sync();
#define GRID_SYNC() xcd_barrier(bar)
    const int tid = threadIdx.x, lane = tid & 63, wave = __builtin_amdgcn_readfirstlane(tid >> 6);
    const int G = gridDim.x, bx = blockIdx.x, vcu = (G % 8 == 0) ? (bx % 8) * (G / 8) + bx / 8 : bx;
    unsigned char* ws = args.ws;
    const float* x = args.in[0]; float* out = args.out;
    bf16* XB = (bf16*)(ws + WS_XB); bf16* GA = (bf16*)(ws + WS_GA); bf16* GB = (bf16*)(ws + WS_GB); bf16* Qb = (bf16*)(ws + WS_Q); bf16* Kb = (bf16*)(ws + WS_K); bf16* Vb = (bf16*)(ws + WS_V);
    bf16* Gb = (bf16*)(ws + WS_G); bf16* AC = (bf16*)(ws + WS_AC); bf16* HB = (bf16*)(ws + WS_HB);
    float* SS = (float*)(ws + WS_SS); float* LF = (float*)(ws + WS_LF); float* CL = (float*)(ws + WS_CL);

    for (int rep0 = 0; rep0 < REP_P0; ++rep0) {
        int tidP = threadIdx.x; asm volatile("" : "+v"(tidP)); const int lane = tidP & 63;
        LAS float* scr = (LAS float*)(lds + wave * 16384);
        const int gw = vcu * NWAVES + wave, NGW = G * NWAVES;
        const bool split = (G == 256);
        for (int it = gw; it < (split ? W_ITEMS : DEPTH * W_ITEMS); it += NGW) weight_item(args, ws, it, scr, lane);
        for (int m0 = gw; m0 < M; m0 += 4 * NGW) {
            f32x4 v[4][4];
#pragma unroll
            for (int r = 0; r < 4; ++r) { const int m = m0 + r * NGW; if (m < M) { const f32x4* xr = (const f32x4*)(x + (size_t)m * D) + lane;
#pragma unroll
                for (int j = 0; j < 4; ++j) v[r][j] = xr[64 * j]; } }
#pragma unroll
            for (int r = 0; r < 4; ++r) { const int m = m0 + r * NGW; if (m < M) { float s = 0.f;
#pragma unroll
                for (int j = 0; j < 4; ++j) s += (v[r][j][0] * v[r][j][0] + v[r][j][1] * v[r][j][1]) + (v[r][j][2] * v[r][j][2] + v[r][j][3] * v[r][j][3]);
                s = wave_sum(s);
                unsigned long long* o8 = (unsigned long long*)(XB + (size_t)m * D) + lane;
#pragma unroll
                for (int j = 0; j < 4; ++j) o8[64 * j] = (unsigned long long)pk2(v[r][j][0], v[r][j][1]) | ((unsigned long long)pk2(v[r][j][2], v[r][j][3]) << 32);
                if (lane < 16) SS[(size_t)m * 16 + lane] = lane == 0 ? s : 0.f; } }
        }
    }
    GRID_SYNC();
    if (threadIdx.x == 0) { unsigned* cw = (unsigned*)(args.ws + WS_CTL); int bad = (gridDim.x != 256u);
        for (unsigned r = 0; r < 8; ++r) bad |= (xb_ld(cw + XB_RMAXA(r)) + xb_ld(cw + XB_RMAXB(r)) != 17u);
        for (unsigned j = 0; j < 16; ++j) { const unsigned c = xb_ld(cw + XB_XCNT(j)); bad |= (c != 0u && c != 32u); }
        *(volatile LAS int*)(lds + LDS_BARST + 48) = bad; }
    __syncthreads();
    const bool aligned = __builtin_amdgcn_readfirstlane(*(volatile LAS int*)(lds + LDS_BARST + 48)) == 0;
#define SEAM_LOCAL() do { if (aligned) xcd_local_barrier(bar, 32u); else xcd_barrier(bar); } while (0)
#ifdef PROBE_ALIGNED
    if (!aligned) for (int eb = 0; eb < 20; ++eb) GRID_SYNC();
#endif

    for (int l = 0; l < DEPTH; ++l) {
        unsigned char* wl = ws + (size_t)l * W_STRIDE;
        for (int rep1 = 0; rep1 < REP_P1; ++rep1) {
            pg8::Gemm g{XB, (const bf16*)(wl + W_IN), M, 11 * 256, D}; pg8::StaticOrder S; S.init(M, 11 * 256, G, bx);
            pg8::EpiInProj E{SS, Gb, Qb, Kb, Vb, LF, args.in[9] + l * 64, args.in[10] + l * 64, args.in[3] + l * NH, attn_body::C2};
            pg8::gemm_phase<pg8::EpiInProj, pg8::StaticOrder, PG8_ALIGN, PG8_SP2>(lds, g, S, E);
        }
        for (int stage = 0; stage < 2; ++stage) {
            if (stage == 1) {
                GRID_SYNC();
                const attn_body::AttnTensors AT{(const attn_body::bf16*)Qb, (const attn_body::bf16*)Kb, (const attn_body::bf16*)Vb, (attn_body::bf16*)Qb, LF, args.in[9] + l * 64, args.in[10] + l * 64};
                attn_body::attn_phase_dyn((char*)lds_raw, AT, (unsigned*)(args.ws + WS_CTL) + 8192 + l * 1024, (volatile LAS int*)(lds + LDS_BARST + 32), (int)bar.x & 7);
            }
#ifndef STAGE0_GATES
#define STAGE0_GATES 1
#endif
            int budget = stage == 0 ? ((G == 256 && bx >= 192) ? STAGE0_GATES : 0) : (1 << 30);
            while (budget-- > 0) {
                const unsigned take = stage == 0 ? 1u : (unsigned)GATE_TAKE;
                const int j = claim_unit((unsigned*)(args.ws + WS_CTL) + 8192 + 512 + l * 1024, (int)bar.x & 7, 64, (volatile LAS int*)(lds + LDS_BARST + 32), take);
                if (j < 0) break;
                const int q = j >> 6, k = j & 63, nu = (64 - k) < (int)take ? (64 - k) : (int)take;
                pg8::Gemm g{XB, (const bf16*)(wl + W_IN) + (size_t)11 * 256 * D, M, 8 * 256, D}; const OneUnit S{q, k, nu};
                pg8::EpiGateSig E{SS, GA, GB};
                pg8::gemm_phase<pg8::EpiGateSig, OneUnit, PG8_ALIGN, PG8_SP2>(lds, g, S, E);
            }
            if (stage == 1) {
                int tidT = threadIdx.x; asm volatile("" : "+v"(tidT));
                conv_phase(lds, (unsigned*)(args.ws + WS_CTL) + 8192 + 2048 + l * 1024, (int)bar.x & 7, (volatile LAS int*)(lds + LDS_BARST + 32), tidT, Gb, args.in[4] + (size_t)l * CW * CC, args.in[5] + l * CC, args.in[6] + l * CC, args.in[7] + l * CC, AC);
            }
        }
        GRID_SYNC();
        {
            static_assert((WS_AC - WS_Q) % ((size_t)256 * CC * 2) == 0 && W_A == W_C + (size_t)D * CC * 2, "the pair order reaches O and the attn-out weights through unit indices");
            constexpr int APM_OFF = (int)((WS_AC - WS_Q) / ((size_t)256 * CC * 2));
            pg8::Gemm g{AC, (const bf16*)(wl + W_C), M, D, CC}; pg8::PairOrder S; S.s.init(M, D, G, bx); S.apm_off = APM_OFF;
            pg8::EpiGatePair E{GA, GB, APM_OFF};
            pg8::gemm_phase<pg8::EpiGatePair, pg8::PairOrder, PG8_ALIGN, PG8_SP2>(lds, g, S, E);
        }
        SEAM_LOCAL();
        {
            pg8::Gemm g{GB, (const bf16*)(wl + W_O), M, D, D}; pg8::StaticOrder S; S.init(M, D, G, bx);
            for (int rep5 = 0; rep5 < REP_P5; ++rep5) { const bool lastr = rep5 + 1 == REP_P5;
            pg8::EpiResid<false> E{out, XB, SS, lastr ? XB : (bf16*)out, lastr ? SS : out + (size_t)M * D / 2};
            pg8::gemm_phase<pg8::EpiResid<false>, pg8::StaticOrder, PG8_ALIGN1, PG8_SP2>(lds, g, S, E); }
        }
        GRID_SYNC();
        for (int rep6 = 0; rep6 < REP_P6; ++rep6) {
            pg8::Gemm g{XB, (const bf16*)(wl + W_F), M, 2 * FF, D}; pg8::StaticOrder S; S.init(M, 2 * FF, G, bx);
            pg8::EpiSwiglu E{SS, HB};
            pg8::gemm_phase<pg8::EpiSwiglu, pg8::StaticOrder, PG8_ALIGN, PG8_SP2>(lds, g, S, E);
#ifdef REP_P6_BAR
            if (rep6 + 1 < REP_P6) GRID_SYNC();
#endif
        }
        if (l == 0 && G == 256 && bx >= 128) {
            int tidW = threadIdx.x; asm volatile("" : "+v"(tidW));
            LAS float* scr = (LAS float*)(lds + wave * 16384);
            for (int it = W_ITEMS + (bx - 128) * NWAVES + wave; it < DEPTH * W_ITEMS; it += 128 * NWAVES) weight_item(args, ws, it, scr, tidW & 63);
        }
        SEAM_LOCAL();
        {
            pg8::Gemm g{HB, (const bf16*)(wl + W_D), M, D, FF}; pg8::StaticOrder S; S.init(M, D, G, bx);
            if (l + 1 < DEPTH) { pg8::EpiResid<false> E{out, XB, SS, XB, SS}; pg8::gemm_phase<pg8::EpiResid<false>, pg8::StaticOrder, PG8_ALIGN1, PG8_SP2>(lds, g, S, E); }
            else { for (int rep7 = 0; rep7 < REP_P7F; ++rep7) { pg8::EpiResid<true> E{out, XB, SS, XB, SS}; pg8::gemm_phase<pg8::EpiResid<true>, pg8::StaticOrder, PG8_ALIGN1, PG8_SP2>(lds, g, S, E); } }
        }
        if (l + 1 < DEPTH) GRID_SYNC();
#ifdef EXTRA_BARS
        for (int eb = 0; eb < EXTRA_BARS; ++eb) GRID_SYNC();
#endif
    }
}

extern "C" void kernel_launch(void* const* d_in, const int* in_sizes, int n_in, void* d_out, int out_size, void* d_ws, size_t ws_size, hipStream_t stream) {
    static int grid = 0;
    if (grid == 0) {
        if (n_in != 16 || in_sizes[0] != M * D || out_size != M * D || ws_size < WS_END) { fprintf(stderr, "kernel_launch: unexpected shapes (n_in %d, in0 %d, out %d, ws %zu)\n", n_in, n_in > 0 ? in_sizes[0] : -1, out_size, ws_size); grid = -1; return; }
        int dev = 0, cus = 0, per_cu = 0;
        if (hipGetDevice(&dev) != hipSuccess || hipDeviceGetAttribute(&cus, hipDeviceAttributeMultiprocessorCount, dev) != hipSuccess) { grid = -1; return; }
        if (hipFuncSetAttribute((const void*)fwd_kernel, hipFuncAttributeMaxDynamicSharedMemorySize, LDS_BYTES) != hipSuccess) { fprintf(stderr, "kernel_launch: hipFuncSetAttribute failed\n"); grid = -1; return; }
        if (hipOccupancyMaxActiveBlocksPerMultiprocessor(&per_cu, (const void*)fwd_kernel, NWAVES * 64, LDS_BYTES) != hipSuccess || per_cu < 1) { fprintf(stderr, "kernel_launch: occupancy query says %d\n", per_cu); per_cu = 1; }
        (void)hipGetLastError();
        grid = cus * 1;
        (void)per_cu;
    }
    if (grid < 0) return;
    if (hipMemsetAsync((char*)d_ws + WS_CTL, 0, CTL_ZERO_BYTES, stream) != hipSuccess) { fprintf(stderr, "kernel_launch: hipMemsetAsync failed\n"); return; }
    Args a{};
    for (int i = 0; i < 16; ++i) a.in[i] = (const float*)d_in[i];
    a.out = (float*)d_out; a.ws = (unsigned char*)d_ws;
    void* params[] = {&a};
    const hipError_t le = hipLaunchCooperativeKernel((const void*)fwd_kernel, dim3(grid), dim3(NWAVES * 64), params, LDS_BYTES, stream);
    if (le != hipSuccess) fprintf(stderr, "kernel_launch: cooperative launch failed: %s (grid %d)\n", hipGetErrorName(le), grid);
}
```

```cpp
#include <hip/hip_runtime.h>
#include <cstdio>
#include <cstdint>
namespace pg8 {
#define PG8_LAS __attribute__((address_space(3)))
typedef unsigned short bf16_t;
typedef short bf16x8 __attribute__((ext_vector_type(8)));
typedef float f32x4 __attribute__((ext_vector_type(4)));
typedef unsigned u32x4 __attribute__((ext_vector_type(4)));
constexpr int BM = 256, BK = 64, HALF = 128, HTB = HALF * BK * 2  , STAGE_BYTES = 8 * HTB, NXCD = 8, WGM = 8;

__host__ __device__ __forceinline__ int lds_byte(int r, int c) { const int st = (r >> 4) * 2 + (c >> 5), rr = r & 15, cc = c & 31, ob = rr * 64 + cc * 2; return st * 1024 + (ob ^ (((ob >> 9) & 1) << 5)); }
__host__ __device__ __forceinline__ void stage_rc(int b, int& R, int& C) { const int st = b / 1024, sb = b % 1024, swz = sb ^ (((sb >> 9) & 1) << 5); R = (st >> 1) * 16 + swz / 64; C = (st & 1) * 32 + (swz % 64) / 2; }
__host__ __device__ __forceinline__ int perm32(int rho) { const int n = rho >> 4, i = rho & 15; return 8 * (i >> 2) + 4 * n + (i & 3); }

struct Unit { int pm, pn; };
struct Gemm { const bf16_t* A; const bf16_t* Bt; int M, N, K; };

struct StaticOrder {
    int nM, nN, nwg, G, c;
    __host__ __device__ void init(int M, int N, int G_, int c_) { nM = M / BM; nN = N / BM; nwg = nM * nN; G = G_; c = c_; }
    __host__ __device__ bool next(int i, Unit& u) const {
        const long L = (long)i * G + c; if (L >= nwg) return false;
        int wgid = (int)L; { const int q = nwg / NXCD, r = nwg % NXCD, xcd = wgid % NXCD, off = wgid / NXCD; wgid = (xcd < r ? xcd * (q + 1) : r * (q + 1) + (xcd - r) * q) + off; }
        const int nig = WGM * nN, gid = wgid / nig, fm = gid * WGM, gsz = (nM - fm) < WGM ? (nM - fm) : WGM;
        u.pm = fm + ((wgid % nig) % gsz); u.pn = (wgid % nig) / gsz; return true;
    }
    __device__ __forceinline__ void a_ready(const Unit&) const {}
    __device__ __forceinline__ void done(const Unit&) const {}
};

typedef float f32x2cv __attribute__((ext_vector_type(2))); typedef __bf16 bf16x2cv __attribute__((ext_vector_type(2)));
__device__ __forceinline__ unsigned cvt_pk_bf16(float lo, float hi) { const f32x2cv v = {lo, hi}; const bf16x2cv b = __builtin_convertvector(v, bf16x2cv); return __builtin_bit_cast(unsigned, b); }
typedef float f32x2 __attribute__((ext_vector_type(2)));
typedef float f32x2 __attribute__((ext_vector_type(2)));
__device__ __forceinline__ float bf_lo(unsigned u) { return __uint_as_float(u << 16); }
__device__ __forceinline__ float bf_hi(unsigned u) { return __uint_as_float(u & 0xffff0000u); }
__device__ __forceinline__ float sigm(float x) { return __builtin_amdgcn_rcpf(1.0f + __expf(-x)); }
__device__ __forceinline__ u32x4 pack8(const f32x4 a, const f32x4 b) { u32x4 w; w.x = cvt_pk_bf16(a[0], a[1]); w.y = cvt_pk_bf16(a[2], a[3]); w.z = cvt_pk_bf16(b[0], b[1]); w.w = cvt_pk_bf16(b[2], b[3]); return w; }
__device__ __forceinline__ void unpack8(const u32x4 w, f32x4& a, f32x4& b) { a = (f32x4){bf_lo(w.x), bf_hi(w.x), bf_lo(w.y), bf_hi(w.y)}; b = (f32x4){bf_lo(w.z), bf_hi(w.z), bf_lo(w.w), bf_hi(w.w)}; }
__device__ __forceinline__ float row_inv(const float* ss, int row) {
    const f32x4* p = (const f32x4*)(ss + (size_t)row * 16);
    const f32x4 a = p[0], b = p[1], c = p[2], d = p[3];
    const float s = (((a[0] + a[1]) + (a[2] + a[3])) + ((b[0] + b[1]) + (b[2] + b[3]))) + (((c[0] + c[1]) + (c[2] + c[3])) + ((d[0] + d[1]) + (d[2] + d[3])));
    return __builtin_amdgcn_rsqf(s * (1.0f / 1024.0f) + 1e-6f);
}

struct EpiGateSig {
    static constexpr bool PERM = true, AFTER_DRAIN = false;
    const float* ss; bf16_t *GA, *GB;
    __device__ __forceinline__ void operator()(const f32x4 (&acc)[2][2][4][2], const Unit& u, int wr, int wc, int fr, int fq) const {
        const int p = u.pn; const int rowb = u.pm * BM + wr * 64 + fr;
        bf16_t* O = p < 4 ? GA : GB; const int cb = (p & 3) * 256;
#pragma unroll
        for (int ai = 0; ai < 2; ++ai)
#pragma unroll
            for (int m = 0; m < 4; ++m) { const int row = rowb + ai * HALF + m * 16; const float inv = row_inv(ss, row);
#pragma unroll
                for (int bj = 0; bj < 2; ++bj) { f32x4 o[2];
#pragma unroll
                    for (int n = 0; n < 2; ++n) { const f32x4 v = acc[ai][bj][m][n] * inv;
#pragma unroll
                        for (int e = 0; e < 4; ++e) o[n][e] = sigm(v[e]); }
                    *(u32x4*)(O + (size_t)row * 1024 + cb + bj * HALF + wc * 32 + fq * 8) = pack8(o[0], o[1]); } }
    }
};
struct EpiInProj {
    static constexpr bool PERM = true, AFTER_DRAIN = false;
    const float* ss; bf16_t *G, *Q, *K, *V; float* LF; const float *gq, *gk, *bfg; float c2;
    __device__ __forceinline__ void operator()(const f32x4 (&acc)[2][2][4][2], const Unit& u, int wr, int wc, int fr, int fq) const {
        const int p = u.pn; const int rowb = u.pm * BM + wr * 64 + fr;
        if (p < 4) {
#pragma unroll
            for (int ai = 0; ai < 2; ++ai)
#pragma unroll
                for (int m = 0; m < 4; ++m) { const int row = rowb + ai * HALF + m * 16; const float inv = row_inv(ss, row);
                    f32x4 o[2];
#pragma unroll
                    for (int n = 0; n < 2; ++n) { const f32x4 v = acc[ai][0][m][n] * inv, g = acc[ai][1][m][n] * inv;
#pragma unroll
                        for (int e = 0; e < 4; ++e) o[n][e] = v[e] * sigm(g[e]); }
                    *(u32x4*)(G + (size_t)row * 512 + p * 128 + wc * 32 + fq * 8) = pack8(o[0], o[1]); }
        } else if (p < 8) {
            const bool isq = p < 6; const float* gp = isq ? gq : gk; bf16_t* O = isq ? Q : K; const float sc = isq ? c2 : 1.0f; const int hh = 4 * (p & 1) + wc;
            f32x4 gv[2][2];
#pragma unroll
            for (int bj = 0; bj < 2; ++bj)
#pragma unroll
                for (int n = 0; n < 2; ++n) gv[bj][n] = *(const f32x4*)(gp + 32 * bj + 8 * fq + 4 * n) * sc;
#pragma unroll
            for (int ai = 0; ai < 2; ++ai)
#pragma unroll
                for (int m = 0; m < 4; ++m) { const int row = rowb + ai * HALF + m * 16; const float inv = row_inv(ss, row);
                    f32x4 a[2][2]; float s = 0.f;
#pragma unroll
                    for (int bj = 0; bj < 2; ++bj)
#pragma unroll
                        for (int n = 0; n < 2; ++n) { a[bj][n] = acc[ai][bj][m][n] * inv; s += (a[bj][n][0] * a[bj][n][0] + a[bj][n][1] * a[bj][n][1]) + (a[bj][n][2] * a[bj][n][2] + a[bj][n][3] * a[bj][n][3]); }
                    s += __shfl_xor(s, 16); s += __shfl_xor(s, 32);
                    const float rinv = __builtin_amdgcn_rsqf(s * (1.0f / 64.0f) + 1e-6f);
#pragma unroll
                    for (int bj = 0; bj < 2; ++bj)
                        *(u32x4*)(O + (size_t)row * 512 + hh * 64 + 32 * bj + 8 * fq) = pack8(a[bj][0] * rinv * gv[bj][0], a[bj][1] * rinv * gv[bj][1]); }
        } else if (p < 10) {
#pragma unroll
            for (int ai = 0; ai < 2; ++ai)
#pragma unroll
                for (int m = 0; m < 4; ++m) { const int row = rowb + ai * HALF + m * 16; const float inv = row_inv(ss, row);
#pragma unroll
                    for (int bj = 0; bj < 2; ++bj)
                        *(u32x4*)(V + (size_t)row * 512 + (p - 8) * 256 + bj * HALF + wc * 32 + fq * 8) = pack8(acc[ai][bj][m][0] * inv, acc[ai][bj][m][1] * inv); }
        } else {
            if (wc == 0 && fq == 0) {
#pragma unroll
                for (int ai = 0; ai < 2; ++ai)
#pragma unroll
                    for (int m = 0; m < 4; ++m) { const int row = rowb + ai * HALF + m * 16; const float inv = row_inv(ss, row); const int b = row >> 13, t = row & 8191;
#pragma unroll
                        for (int n = 0; n < 2; ++n)
#pragma unroll
                            for (int e = 0; e < 4; ++e) { const int h = 4 * n + e; const float z = acc[ai][0][m][n][e] * inv + bfg[h];
                                const float lf = fminf(z, 0.f) - __logf(1.0f + __expf(-fabsf(z)));
                                LF[(size_t)(b * 8 + h) * 8192 + t] = lf; } }
            }
        }
    }
};
struct EpiGatePair {
    static constexpr bool PERM = true, AFTER_DRAIN = false;
    bf16_t *GA, *GB; int apm_off;
    __device__ __forceinline__ void operator()(const f32x4 (&acc)[2][2][4][2], const Unit& u, int wr, int wc, int fr, int fq) const {
        const bool second = u.pn >= 4; const int pm = second ? u.pm + apm_off : u.pm, pn = second ? u.pn - 4 : u.pn;
        bf16_t* IO = second ? GB : GA;
        const int rowb = pm * BM + wr * 64 + fr, colb = pn * BM + wc * 32 + fq * 8;
#pragma unroll
        for (int ai = 0; ai < 2; ++ai)
#pragma unroll
            for (int m = 0; m < 4; ++m) { const int row = rowb + ai * HALF + m * 16;
#pragma unroll
                for (int bj = 0; bj < 2; ++bj) { const size_t off = (size_t)row * 1024 + colb + bj * HALF;
                    f32x4 g0, g1; unpack8(*(const u32x4*)(IO + off), g0, g1);
                    f32x4 o0 = g0 * acc[ai][bj][m][0], o1 = g1 * acc[ai][bj][m][1];
                    if (second) { f32x4 y0, y1; unpack8(*(const u32x4*)(GA + off), y0, y1); o0 += y0; o1 += y1; }
                    *(u32x4*)(IO + off) = pack8(o0, o1); } }
    }
};
struct PairOrder { StaticOrder s; int apm_off;
    __device__ __forceinline__ bool next(int i, Unit& u) const { if (i >= 2) return false; if (!s.next(0, u)) return false; if (i == 1) { u.pm -= apm_off; u.pn += 4; } return true; }
    __device__ __forceinline__ void a_ready(const Unit&) const {}
    __device__ __forceinline__ void done(const Unit&) const {} };
template <bool FINAL> struct EpiResid {
    static constexpr bool PERM = true, AFTER_DRAIN = false;
    float* Xout; bf16_t* XB; float* SS; bf16_t* XBo; float* SSo;
    __device__ __forceinline__ void operator()(const f32x4 (&acc)[2][2][4][2], const Unit& u, int wr, int wc, int fr, int fq) const {
        const int rowb = u.pm * BM + wr * 64 + fr, colb = u.pn * BM + wc * 32 + fq * 8;
#pragma unroll
        for (int ai = 0; ai < 2; ++ai)
#pragma unroll
            for (int m = 0; m < 4; ++m) { const int row = rowb + ai * HALF + m * 16; float s = 0.f;
#pragma unroll
                for (int bj = 0; bj < 2; ++bj) { const size_t off = (size_t)row * 1024 + colb + bj * HALF;
                    f32x4 x0, x1; unpack8(*(const u32x4*)(XB + off), x0, x1); x0 += acc[ai][bj][m][0]; x1 += acc[ai][bj][m][1];
                    if (FINAL) { *(f32x4*)(Xout + off) = x0; *(f32x4*)(Xout + off + 4) = x1; }
                    else { const u32x4 w = pack8(x0, x1); *(u32x4*)(XBo + off) = w; unpack8(w, x0, x1);
                        s += ((x0[0] * x0[0] + x0[1] * x0[1]) + (x0[2] * x0[2] + x0[3] * x0[3])) + ((x1[0] * x1[0] + x1[1] * x1[1]) + (x1[2] * x1[2] + x1[3] * x1[3])); } }
                if (!FINAL) { s += __shfl_xor(s, 16); s += __shfl_xor(s, 32);
                    if (fq == 0) SSo[(size_t)row * 16 + u.pn * 4 + wc] = s; } }
    }
};
struct EpiSwiglu {
    static constexpr bool PERM = true, AFTER_DRAIN = false;
    const float* ss; bf16_t* HB;
    __device__ __forceinline__ void operator()(const f32x4 (&acc)[2][2][4][2], const Unit& u, int wr, int wc, int fr, int fq) const {
        const int rowb = u.pm * BM + wr * 64 + fr;
#pragma unroll
        for (int ai = 0; ai < 2; ++ai)
#pragma unroll
            for (int m = 0; m < 4; ++m) { const int row = rowb + ai * HALF + m * 16; const float inv = row_inv(ss, row);
                f32x4 o[2];
#pragma unroll
                for (int n = 0; n < 2; ++n) { const f32x4 g = acc[ai][0][m][n] * inv, v = acc[ai][1][m][n] * inv;
#pragma unroll
                    for (int e = 0; e < 4; ++e) o[n][e] = g[e] * sigm(g[e]) * v[e]; }
                *(u32x4*)(HB + (size_t)row * 2816 + u.pn * 128 + wc * 32 + fq * 8) = pack8(o[0], o[1]); }
    }
};

template <class Epi, class Sched, bool ALIGN_EPI = false, bool SP2 = false>
__device__ __forceinline__ void gemm_phase(PG8_LAS unsigned char* lds, const Gemm g, const Sched& S, const Epi& E) {
    int tid = threadIdx.x; asm volatile("" : "+v"(tid));
    const int wid = __builtin_amdgcn_readfirstlane(tid >> 6), lane = tid & 63, wr = wid >> 2, wc = wid & 3, fr = lane & 15, fq = lane >> 4;
    const int K = g.K, nt = K / BK;
    unsigned voffA[2], voffB[2];
#pragma unroll
    for (int i = 0; i < 2; ++i) { int R, C; stage_rc(tid * 16 + i * 8192, R, C); const int Rb = Epi::PERM ? ((R & ~31) + perm32(R & 31)) : R;
        voffA[i] = (unsigned)(R * K + C) * 2u; voffB[i] = (unsigned)(Rb * K + C) * 2u; }
    const size_t kstep = (size_t)(BK * 2);
    const size_t hstep = (size_t)HALF * K * 2;
    const size_t tstep = 2 * hstep;
    const unsigned ldsw = (unsigned)wid * 1024u;
    const int aoff = lds_byte(wr * 64 + fr, fq * 8), boff = lds_byte(wc * 32 + fr, fq * 8);
#define PG8_SA(b, h) (((b) * 2 + (h)) * HTB)
#define PG8_SB(b, h) ((4 + (b) * 2 + (h)) * HTB)
#define PG8_STAGE(bufoff, gbase, voff) do { _Pragma("unroll") for (int _i = 0; _i < 2; ++_i) \
        __builtin_amdgcn_global_load_lds((const unsigned*)((const char*)(gbase) + (voff)[_i]), (PG8_LAS unsigned*)(lds + (bufoff) + ldsw + _i * 8192), 16, 0, 0); } while (0)
#define PG8_LDA(dst, b, h) do { _Pragma("unroll") for (int m = 0; m < 4; ++m) _Pragma("unroll") for (int k = 0; k < 2; ++k) dst[m][k] = *(const PG8_LAS bf16x8*)(lds + PG8_SA(b, h) + aoff + m * 2048 + k * 1024); } while (0)
#define PG8_LDB(dst, b, h) do { _Pragma("unroll") for (int n = 0; n < 2; ++n) _Pragma("unroll") for (int k = 0; k < 2; ++k) dst[n][k] = *(const PG8_LAS bf16x8*)(lds + PG8_SB(b, h) + boff + n * 2048 + k * 1024); } while (0)
#define PG8_MMA(ai, bj, At, Bt) do { __builtin_amdgcn_s_setprio(1); _Pragma("unroll") for (int m = 0; m < 4; ++m) _Pragma("unroll") for (int n = 0; n < 2; ++n) _Pragma("unroll") for (int k = 0; k < 2; ++k) \
        acc[ai][bj][m][n] = __builtin_amdgcn_mfma_f32_16x16x32_bf16(Bt[n][k], At[m][k], acc[ai][bj][m][n], 0, 0, 0); __builtin_amdgcn_s_setprio(0); } while (0)
#define PG8_WAIT_V(n) asm volatile("s_waitcnt vmcnt(" #n ")" ::: "memory")
#define PG8_WAIT_L(n) asm volatile("s_waitcnt lgkmcnt(" #n ")" ::: "memory")
#define PG8_BAR __builtin_amdgcn_s_barrier()
#define PG8_SCHED __builtin_amdgcn_sched_barrier(0)
    Unit cur, nxt; int ui = 0;
    if (!S.next(0, cur)) return;
    f32x4 acc[2][2][4][2];
#pragma unroll
    for (int a = 0; a < 2; ++a)
#pragma unroll
        for (int b = 0; b < 2; ++b)
#pragma unroll
            for (int m = 0; m < 4; ++m)
#pragma unroll
                for (int n = 0; n < 2; ++n) acc[a][b][m][n] = (f32x4){0.f, 0.f, 0.f, 0.f};
    bf16x8 At[4][2], B0[2][2], B1[2][2];
    const char* cA = (const char*)g.A + (size_t)cur.pm * tstep; const char* cB = (const char*)g.Bt + (size_t)cur.pn * tstep;
    S.a_ready(cur);
    if constexpr (SP2) {
        PG8_STAGE(PG8_SB(0, 0), cB, voffB); PG8_STAGE(PG8_SB(0, 1), cB + hstep, voffB); PG8_STAGE(PG8_SA(0, 0), cA, voffA); PG8_STAGE(PG8_SA(0, 1), cA + hstep, voffA);
        if (wr == 1) PG8_BAR;
        PG8_WAIT_V(2); PG8_BAR;
        PG8_STAGE(PG8_SB(1, 0), cB + kstep, voffB); PG8_STAGE(PG8_SA(1, 0), cA + kstep, voffA); PG8_STAGE(PG8_SB(1, 1), cB + hstep + kstep, voffB);
        PG8_WAIT_V(6); PG8_BAR;
    } else {
        PG8_STAGE(PG8_SB(0, 0), cB, voffB); PG8_STAGE(PG8_SA(0, 0), cA, voffA); PG8_STAGE(PG8_SB(0, 1), cB + hstep, voffB); PG8_STAGE(PG8_SA(0, 1), cA + hstep, voffA);
        if (wr == 1) PG8_BAR;
        PG8_WAIT_V(4); PG8_BAR;
        PG8_STAGE(PG8_SB(1, 0), cB + kstep, voffB); PG8_STAGE(PG8_SA(1, 0), cA + kstep, voffA); PG8_STAGE(PG8_SB(1, 1), cB + hstep + kstep, voffB);
        PG8_WAIT_V(6); PG8_BAR;
    }
    for (;;) {
        const bool has_next = S.next(ui + 1, nxt);
        const char* nA = has_next ? (const char*)g.A + (size_t)nxt.pm * tstep : cA; const char* nB = has_next ? (const char*)g.Bt + (size_t)nxt.pn * tstep : cB;
        for (int t = 0; t < nt; t += 2) {
            const bool last = (t == nt - 2);
            const char* a1 = cA + (size_t)(t + 1) * kstep;
            const char* a2 = last ? nA : cA + (size_t)(t + 2) * kstep; const char* b2 = last ? nB : cB + (size_t)(t + 2) * kstep;
            const char* a3 = a2 + kstep; const char* b3 = b2 + kstep;
            if (last && has_next) S.a_ready(nxt);
            if constexpr (SP2) {
            PG8_LDB(B0, 0, 0); PG8_LDB(B1, 0, 1); PG8_SCHED; PG8_LDA(At, 0, 0); PG8_STAGE(PG8_SA(1, 1), a1 + hstep, voffA);
            PG8_WAIT_V(8); PG8_WAIT_L(0); PG8_BAR; PG8_MMA(0, 0, At, B0); PG8_MMA(0, 1, At, B1); PG8_BAR; PG8_SCHED;
            PG8_LDA(At, 0, 1); PG8_STAGE(PG8_SB(0, 0), b2, voffB); PG8_STAGE(PG8_SB(0, 1), b2 + hstep, voffB); PG8_STAGE(PG8_SA(0, 0), a2, voffA);
            PG8_WAIT_V(8); PG8_WAIT_L(0); PG8_BAR; PG8_MMA(1, 0, At, B0); PG8_MMA(1, 1, At, B1); PG8_BAR; PG8_SCHED;
            PG8_LDB(B0, 1, 0); PG8_LDB(B1, 1, 1); PG8_SCHED; PG8_LDA(At, 1, 0); PG8_STAGE(PG8_SA(0, 1), a2 + hstep, voffA);
            PG8_WAIT_V(8); PG8_WAIT_L(0); PG8_BAR; PG8_MMA(0, 0, At, B0); PG8_MMA(0, 1, At, B1); PG8_BAR; PG8_SCHED;
            PG8_LDA(At, 1, 1); PG8_STAGE(PG8_SB(1, 0), b3, voffB); PG8_STAGE(PG8_SB(1, 1), b3 + hstep, voffB); PG8_STAGE(PG8_SA(1, 0), a3, voffA);
            PG8_WAIT_V(8); PG8_WAIT_L(0); PG8_BAR; PG8_MMA(1, 0, At, B0); PG8_MMA(1, 1, At, B1); PG8_BAR; PG8_SCHED;
            } else {
            PG8_LDB(B0, 0, 0); PG8_SCHED; PG8_LDA(At, 0, 0); PG8_STAGE(PG8_SA(1, 1), a1 + hstep, voffA);
            PG8_WAIT_L(8); PG8_BAR; PG8_WAIT_L(0); PG8_MMA(0, 0, At, B0); PG8_BAR; PG8_SCHED;
            PG8_LDB(B1, 0, 1); PG8_STAGE(PG8_SB(0, 0), b2, voffB);
            PG8_BAR; PG8_WAIT_L(0); PG8_MMA(0, 1, At, B1); PG8_BAR;
            PG8_LDA(At, 0, 1); PG8_STAGE(PG8_SA(0, 0), a2, voffA);
            PG8_BAR; PG8_WAIT_L(0); PG8_MMA(1, 0, At, B0); PG8_BAR; PG8_SCHED;
            PG8_STAGE(PG8_SB(0, 1), b2 + hstep, voffB);
            PG8_WAIT_V(6); PG8_BAR; PG8_MMA(1, 1, At, B1); PG8_BAR;
            PG8_LDB(B0, 1, 0); PG8_SCHED; PG8_LDA(At, 1, 0); PG8_STAGE(PG8_SA(0, 1), a2 + hstep, voffA);
            PG8_WAIT_L(8); PG8_BAR; PG8_WAIT_L(0); PG8_MMA(0, 0, At, B0); PG8_BAR; PG8_SCHED;
            PG8_LDB(B1, 1, 1); PG8_STAGE(PG8_SB(1, 0), b3, voffB);
            PG8_BAR; PG8_WAIT_L(0); PG8_MMA(0, 1, At, B1); PG8_BAR;
            PG8_LDA(At, 1, 1); PG8_STAGE(PG8_SA(1, 0), a3, voffA);
            PG8_BAR; PG8_WAIT_L(0); PG8_MMA(1, 0, At, B0); PG8_BAR; PG8_SCHED;
            PG8_STAGE(PG8_SB(1, 1), b3 + hstep, voffB);
            PG8_WAIT_V(6); PG8_BAR; PG8_MMA(1, 1, At, B1); PG8_BAR;
            }
        }
        if constexpr (ALIGN_EPI) { if (wr == 0) PG8_BAR; }
        if constexpr (!Epi::AFTER_DRAIN) { E(acc, cur, wr, wc, fr, fq); S.done(cur); }
        if (!has_next) break;
#pragma unroll
        for (int a = 0; a < 2; ++a)
#pragma unroll
            for (int b = 0; b < 2; ++b)
#pragma unroll
                for (int m = 0; m < 4; ++m)
#pragma unroll
                    for (int n = 0; n < 2; ++n) acc[a][b][m][n] = (f32x4){0.f, 0.f, 0.f, 0.f};
        cur = nxt; cA = nA; cB = nB; ++ui;
        if constexpr (ALIGN_EPI) { if (wr == 1) PG8_BAR; }
    }
    PG8_WAIT_V(0);
    if constexpr (!ALIGN_EPI) { if (wr == 0) PG8_BAR; }
    PG8_BAR;
    if constexpr (Epi::AFTER_DRAIN) { E.fused(acc, cur, wr, wc, fr, fq, lds, wid, lane); S.done(cur); }
#undef PG8_SA
#undef PG8_SB
#undef PG8_STAGE
#undef PG8_LDA
#undef PG8_LDB
#undef PG8_MMA
#undef PG8_WAIT_V
#undef PG8_WAIT_L
#undef PG8_BAR
#undef PG8_SCHED
}
}

#ifndef PG8_SP2
#define PG8_SP2 true
#endif
#ifndef PG8_ALIGN
#define PG8_ALIGN true
#endif
#include <hip/hip_bf16.h>
#include <cmath>
namespace attn_body {
using bf16=__hip_bfloat16;
using bf16x8=__attribute__((ext_vector_type(8)))short;
using s16x4=__attribute__((ext_vector_type(4)))short;
using f32x16=__attribute__((ext_vector_type(16)))float;
using u32x4=__attribute__((ext_vector_type(4)))unsigned;
constexpr int BATCH=2,NHEAD=8,SEQ=8192,D=64,DM=NHEAD*D;
constexpr int NW=8,QBLK=32,QB=QBLK*NW,KVBLK=64,NQB=SEQ/QB;
constexpr int ATTN_PITCH=DM, ATTN_UNIT_ROWS=QB;
__device__ __forceinline__ int crow(int r,int hi){return (r&3)+8*(r>>2)+4*hi;}
#define SBAR() __builtin_amdgcn_sched_barrier(0)
__device__ __forceinline__ void cmask(f32x16&p0,f32x16&p1,int jb,int qrel,int hi){
  const float NEG=-INFINITY; int kb=64*jb+4*hi;
  #pragma unroll
  for(int r=0;r<16;++r){int kv=kb+(r&3)+8*(r>>2); if(kv>qrel)p0[r]=NEG; if(kv+32>qrel)p1[r]=NEG;}
}

constexpr int NSLOT=3, SLOTB=8192;
constexpr int LDS_K=0, LDS_V=NSLOT*SLOTB, LDS_WS=2*NSLOT*SLOTB, LDS_OST=LDS_WS+NW*64*4, LDS_CL=86016, LDS_BYTES=LDS_CL+SEQ*4;
constexpr float C2=0.125f*1.4426950408889634f;
__device__ __forceinline__ void glds16(const void*gsrc,unsigned lds_dst){unsigned keep;
  asm volatile("s_mov_b32 %0, m0\n\ts_mov_b32 m0, %2\n\ts_nop 0\n\tglobal_load_lds_dwordx4 %1, off\n\ts_mov_b32 m0, %0":"=&s"(keep):"v"(gsrc),"s"(lds_dst):"memory");}
__device__ __forceinline__ float max3f(float a,float b,float c){float r;asm("v_max3_f32 %0, %1, %2, %3":"=v"(r):"v"(a),"v"(b),"v"(c));return r;}
__device__ __forceinline__ float max2f(float a,float b){float r;asm("v_max_f32_e32 %0, %1, %2":"=v"(r):"v"(a),"v"(b));return r;}
__device__ __forceinline__ float fadd_s(float a,float b){float r;asm("v_add_f32_e32 %0, %1, %2":"=v"(r):"v"(a),"v"(b));return r;}
__device__ __forceinline__ float fsub_s(float a,float b){float r;asm("v_sub_f32_e32 %0, %1, %2":"=v"(r):"v"(a),"v"(b));return r;}
typedef float f32x2_t __attribute__((ext_vector_type(2))); typedef __bf16 bf16x2_t __attribute__((ext_vector_type(2)));
__device__ __forceinline__ unsigned cvtpk_s(float lo,float hi){f32x2_t v={lo,hi};bf16x2_t b=__builtin_convertvector(v,bf16x2_t);return __builtin_bit_cast(unsigned,b);}
#define WAIT_BAR(N) asm volatile("s_waitcnt vmcnt(" #N ") lgkmcnt(0)\n\ts_barrier":::"memory")

__device__ __forceinline__ void qkt(f32x16&p0,f32x16&p1,const char*Kslot,const bf16x8*qr,int r32,int hi){
  const char*kb=Kslot+hi*1024+r32*16;
  #pragma unroll
  for(int d0=0;d0<4;++d0){
    const bf16x8 b0=*reinterpret_cast<const bf16x8*>(kb+d0*2048);
    const bf16x8 b1=*reinterpret_cast<const bf16x8*>(kb+d0*2048+512);
    p0=__builtin_amdgcn_mfma_f32_32x32x16_bf16(b0,qr[d0],p0,0,0,0);p1=__builtin_amdgcn_mfma_f32_32x32x16_bf16(b1,qr[d0],p1,0,0,0);}
}
typedef __attribute__((address_space(3))) const char* lds_cptr;
typedef short v4i16_t __attribute__((ext_vector_type(4)));
__device__ __forceinline__ void kload8(bf16x8*kf,lds_cptr kp){
  kf[0]=*(const __attribute__((address_space(3))) bf16x8*)(kp);      kf[1]=*(const __attribute__((address_space(3))) bf16x8*)(kp+512);
  kf[2]=*(const __attribute__((address_space(3))) bf16x8*)(kp+2048); kf[3]=*(const __attribute__((address_space(3))) bf16x8*)(kp+2560);
  kf[4]=*(const __attribute__((address_space(3))) bf16x8*)(kp+4096); kf[5]=*(const __attribute__((address_space(3))) bf16x8*)(kp+4608);
  kf[6]=*(const __attribute__((address_space(3))) bf16x8*)(kp+6144); kf[7]=*(const __attribute__((address_space(3))) bf16x8*)(kp+6656);
}
__device__ __forceinline__ void kload2(bf16x8*kf,lds_cptr kp,int j){ kf[2*j]=*(const __attribute__((address_space(3))) bf16x8*)(kp+j*2048); kf[2*j+1]=*(const __attribute__((address_space(3))) bf16x8*)(kp+j*2048+512); }
__device__ __forceinline__ s16x4 vtr(lds_cptr p){ return __builtin_bit_cast(s16x4,__builtin_amdgcn_ds_read_tr16_b64_v4i16((__attribute__((address_space(3))) v4i16_t*)p)); }
__device__ __forceinline__ float rowmax(const f32x16&p0,const f32x16&p1){
  float a=max3f(p0[0],p0[1],p1[0]),b=max3f(p0[2],p0[3],p1[1]);a=max3f(a,p1[2],p1[3]);
  #pragma unroll
  for(int r=4;r<16;r+=4){a=max3f(a,p0[r],p0[r+1]);b=max3f(b,p0[r+2],p0[r+3]);a=max3f(a,p1[r],p1[r+1]);b=max3f(b,p1[r+2],p1[r+3]);}
  const float m=max2f(a,b);
  auto rr=__builtin_amdgcn_permlane32_swap(__float_as_uint(m),__float_as_uint(m),false,false);
  return max2f(__uint_as_float(rr[0]),__uint_as_float(rr[1]));
}
__device__ __forceinline__ void pv(f32x16*o,int vb,bf16x8 pa0,bf16x8 pa1,bf16x8 pa2,bf16x8 pa3){
  #pragma unroll
  for(int d0=0;d0<2;++d0){s16x4 lo[4],hi[4];
    #pragma unroll
    for(int ks=0;ks<4;++ks){
      asm volatile("ds_read_b64_tr_b16 %0,%1 offset:%c2":"=&v"(lo[ks]):"v"(vb),"i"(d0*4096+ks*1024):"memory");
      asm volatile("ds_read_b64_tr_b16 %0,%1 offset:%c2":"=&v"(hi[ks]):"v"(vb),"i"(d0*4096+ks*1024+512):"memory");}
    asm volatile("s_waitcnt lgkmcnt(0)":::"memory");SBAR();
    #define PK(k) (bf16x8){lo[k][0],lo[k][1],lo[k][2],lo[k][3],hi[k][0],hi[k][1],hi[k][2],hi[k][3]}
    o[d0]=__builtin_amdgcn_mfma_f32_32x32x16_bf16(pa0,PK(0),o[d0],0,0,0);
    o[d0]=__builtin_amdgcn_mfma_f32_32x32x16_bf16(pa1,PK(1),o[d0],0,0,0);
    o[d0]=__builtin_amdgcn_mfma_f32_32x32x16_bf16(pa2,PK(2),o[d0],0,0,0);
    o[d0]=__builtin_amdgcn_mfma_f32_32x32x16_bf16(pa3,PK(3),o[d0],0,0,0);
    #undef PK
  }
}

#ifndef ATTN_STORE16
#define ATTN_STORE16(p,v) (*(u32x4*)(p)=(v))
#endif
template<int THRL> __device__ __forceinline__ void attn_unit(int b,int h,int qb,const bf16*Q,const bf16*__restrict__ K,const bf16*__restrict__ V,bf16*O,const float*__restrict__ CLg,const float*__restrict__ GQg,const float*__restrict__ GKg,char*shm){
  int tid=threadIdx.x; asm volatile("":"+v"(tid)); const int lane=tid&63,r32=lane&31,hi=lane>>5; const int wid=__builtin_amdgcn_readfirstlane(tid>>6);
  const long rowbase=(long)b*SEQ; const int q0=qb*QB;
  const bf16*Qw=Q+(rowbase+q0+wid*QBLK)*DM+h*D;
  const lds_cptr shm3=(lds_cptr)shm;
  const unsigned lds0=(unsigned)(uintptr_t)shm;
  float*wsf=(float*)(shm+LDS_WS)+wid*64;
  typedef __attribute__((address_space(3))) float lds_f32; typedef float f32x4_t __attribute__((ext_vector_type(4)));
  lds_f32* const cl3=(lds_f32*)(shm3+LDS_CL);
  bf16x8 qr[4];
  #pragma unroll
  for(int d0=0;d0<4;++d0)qr[d0]=*reinterpret_cast<const bf16x8*>(&Qw[(long)r32*DM+d0*16+hi*8]);
  const float mq0_=GQg[lane],mk0_=GKg[lane];
  { const float*cg=CLg+((long)(b*NHEAD+h))*SEQ;
    const int n_=q0+QB; f32x4_t v_[4]; float run_=0.f;
    if(tid*16<n_){
      #pragma unroll
      for(int j_=0;j_<4;++j_)v_[j_]=*(const f32x4_t*)(cg+tid*16+4*j_);
      #pragma unroll
      for(int j_=0;j_<4;++j_){
        #pragma unroll
        for(int e_=0;e_<4;++e_){run_+=v_[j_][e_];v_[j_][e_]=run_;} } }
    float inc_=run_;
    #pragma unroll
    for(int o_=1;o_<64;o_<<=1){ const float y_=__shfl_up(inc_,o_); if(lane>=o_)inc_+=y_; }
    lds_f32* const wt_=(lds_f32*)(shm3+LDS_WS);
    if(lane==63)wt_[wid]=inc_;
    asm volatile("s_waitcnt vmcnt(0) lgkmcnt(0)\n\ts_barrier":::"memory");
    float off_=inc_-run_;
    for(int w_=0;w_<wid;++w_)off_+=wt_[w_];
    if(tid*16<n_){
      #pragma unroll
      for(int j_=0;j_<4;++j_)*(__attribute__((address_space(3))) f32x4_t*)(cl3+tid*16+4*j_)=(v_[j_]+off_)*1.4426950408889634f; }
    asm volatile("s_waitcnt vmcnt(0) lgkmcnt(0)\n\ts_barrier":::"memory"); }
  int t_start=0; bool chk_=true;
  { float mq=fabsf(mq0_),mk=fabsf(mk0_);
    #pragma unroll
    for(int o_=1;o_<64;o_<<=1){ mq=fmaxf(mq,__shfl_xor(mq,o_)); mk=fmaxf(mk,__shfl_xor(mk,o_)); }
    const float thr=-(40.0f+2.0f*8.0f*1.4426950408889634f*mq*mk), cq0=cl3[q0]; const int kmax=(q0+QB)/KVBLK/2-2; int kk=0;
    #pragma unroll
    for(int st_=32;st_>=1;st_>>=1){ const int c_=kk+st_; if(c_<=kmax){ if(cq0-cl3[128*c_-1]<thr)kk=c_; } }
    t_start=__builtin_amdgcn_readfirstlane(2*kk);
    chk_=__builtin_amdgcn_readfirstlane((int)!(8.0f*1.4426950408889634f*mq*mk*1.01f<(float)THRL-0.5f))!=0; }
  const int NT=(q0+QB)/KVBLK-t_start;
  lds_f32* const cl3t=cl3+t_start*KVBLK;
  const bf16*Kh=K+(rowbase+(long)t_start*KVBLK)*DM+h*D,*Vh=V+(rowbase+(long)t_start*KVBLK)*DM+h*D;
  const float cli=cl3[q0+wid*QBLK+r32];
  const bf16*ksrc=Kh+(long)lane*DM+wid*8;
  const bf16*vsrc=Vh+(long)(16*(wid&3)+(lane>>2))*DM+(wid>>2)*32+(lane&3)*8;
  const unsigned kdst=lds0+LDS_K+wid*1024, vdst=lds0+LDS_V+wid*1024;
  #define DMA_K(t,slot) glds16(ksrc+(long)(t)*KVBLK*DM,(unsigned)__builtin_amdgcn_readfirstlane(kdst+(slot)))
  #define DMA_V(t,slot) glds16(vsrc+(long)(t)*KVBLK*DM,(unsigned)__builtin_amdgcn_readfirstlane(vdst+(slot)))
  const int vb0=(int)(lds0+LDS_V)+((lane>>4)&1)*32+(lane&3)*8+(4*hi+((lane&15)>>2))*64;
  const char*Kbase=shm+LDS_K; bf16x8 kf[8];
  const lds_cptr kp0=shm3+LDS_K+hi*1024+r32*16; const lds_cptr vp0=shm3+LDS_V+((lane>>4)&1)*32+(lane&3)*8+(4*hi+((lane&15)>>2))*64;
  #define BIASFILL(X0,X1,t) do{ const lds_f32* cp_=cl3t+(t)*KVBLK+4*hi; const float bs_=cli-mhat; \
    _Pragma("unroll") for(int g_=0;g_<4;++g_){ const f32x4_t a_=*(const __attribute__((address_space(3))) f32x4_t*)(cp_+8*g_); const f32x4_t b_=*(const __attribute__((address_space(3))) f32x4_t*)(cp_+32+8*g_); \
      _Pragma("unroll") for(int e_=0;e_<4;++e_){ X0[4*g_+e_]=bs_-a_[e_]; X1[4*g_+e_]=bs_-b_[e_]; } } }while(0)
  DMA_K(0,0);DMA_V(0,0);DMA_K(1,SLOTB);
  float mhat=0.f,l_reg=0.f;f32x16 o[2];o[0]=f32x16{};o[1]=f32x16{};
  const int qrel=wid*QBLK+r32;
  #define CMASK(P0,P1,t) do{int jb_=(t)-(NT-4); if(jb_>=0)cmask(P0,P1,jb_,qrel,hi);}while(0)
  bool resc=false;
  #define START(P0,P1) do{ const float rm=rowmax(P0,P1); resc=false; \
    { const float dl=max2f(rm,0.f); mhat=fadd_s(mhat,dl); \
      _Pragma("unroll") for(int r=0;r<16;++r){P0[r]=fsub_s(P0[r],dl);P1[r]=fsub_s(P1[r],dl);} } \
    _Pragma("unroll") for(int r=0;r<16;++r)P0[r]=__builtin_amdgcn_exp2f(P0[r]); }while(0)
  #define RESC() do{ if(resc){ asm volatile("s_waitcnt lgkmcnt(0)":::"memory"); \
      _Pragma("unroll") for(int d_=0;d_<2;++d_) _Pragma("unroll") for(int r=0;r<16;++r)o[d_][r]*=wsf[crow(r,hi)]; } }while(0)
  f32x16 pA0,pA1,pB0,pB1;
  int sl_prev=0,sl_cur=0,sl_next=SLOTB;
  #define ROT() do{sl_prev=sl_cur;sl_cur=sl_next;sl_next=(sl_next==(NSLOT-1)*SLOTB)?0:sl_next+SLOTB;}while(0)
  DMA_K(2,2*SLOTB);
  WAIT_BAR(3);
  BIASFILL(pA0,pA1,0); qkt(pA0,pA1,Kbase,qr,r32,hi);asm volatile("s_nop 15\n\ts_nop 7":"+v"(pA0),"+v"(pA1));CMASK(pA0,pA1,0);
  START(pA0,pA1);
  _Pragma("unroll") for(int r=0;r<16;++r)pA1[r]=__builtin_amdgcn_exp2f(pA1[r]);
  BIASFILL(pB0,pB1,1);
  WAIT_BAR(0);
  DMA_K(3,0);DMA_V(1,SLOTB);
  ROT();
  kload8(kf,kp0+sl_cur);
  WAIT_BAR(2);
  s16x4 vlo[8],vhi[8]; u32x4 pw0,pw1,pw2,pw3;
  #define PKW(P,B) cvtpk_s(P[B],P[B+1])
  #define PAF(k) __builtin_bit_cast(bf16x8,pw##k)
  #define VFR(i) (bf16x8){vlo[i][0],vlo[i][1],vlo[i][2],vlo[i][3],vhi[i][0],vhi[i][1],vhi[i][2],vhi[i][3]}
  #define PIN(x) asm volatile("":"+v"(x))
  #define MX3(a,b,c) __builtin_fmaxf(__builtin_fmaxf((a),(b)),(c))
  #define GAPA(MF,A0,A1,A2,A3,W0,W1,PW) do{ MF; sacc+=A0; sacc+=A1; sacc+=A2; sacc+=A3; PIN(sacc); W0; W1; PIN(PW); SBAR(); }while(0)
  #define EX(v) __builtin_amdgcn_exp2f(v)
  #define GAPB(MF,X,B,GF_,Y,OFF) do{ MF; f32x4_t bl_; if(GF_){ bl_=*(const __attribute__((address_space(3))) f32x4_t*)(bcp_+(OFF)); } \
    X[B]=EX(X[B]); X[B+1]=EX(X[B+1]); X[B+2]=EX(X[B+2]); X[B+3]=EX(X[B+3]); PIN(X); \
    if(GF_){ Y[B]=bbs_-bl_[0]; Y[B+1]=bbs_-bl_[1]; Y[B+2]=bbs_-bl_[2]; Y[B+3]=bbs_-bl_[3]; PIN(Y); } SBAR(); }while(0)
  #define VRD(i) do{ vlo[i]=vtr(vp_+(((i)>>2)*4096+((i)&3)*1024)); vhi[i]=vtr(vp_+(((i)>>2)*4096+((i)&3)*1024+512)); }while(0)
  #define KRD(G,j) do{ if(G){ kload2(kf,kp0+sl_next,j); SBAR(); } }while(0)
  #define STEP(C0,C1,P0,P1,t,GK,GV,GL,GF) do{ SBAR(); \
    const lds_cptr vp_=vp0+sl_prev; \
    VRD(0); SBAR(); float sacc=(P0[0]+P0[1]); \
    GAPA(C0=__builtin_amdgcn_mfma_f32_32x32x16_bf16(kf[0],qr[0],C0,0,0,0), P0[2],P0[3],P0[4],P0[5],     pw0[0]=PKW(P0,0), pw0[1]=PKW(P0,2), pw0); \
    VRD(4); SBAR(); GAPA(C1=__builtin_amdgcn_mfma_f32_32x32x16_bf16(kf[1],qr[0],C1,0,0,0), P0[6],P0[7],P0[8],P0[9],     pw0[2]=PKW(P0,4), pw0[3]=PKW(P0,6), pw0); \
    VRD(1); SBAR(); GAPA(C0=__builtin_amdgcn_mfma_f32_32x32x16_bf16(kf[2],qr[1],C0,0,0,0),   P0[10],P0[11],P0[12],P0[13], pw1[0]=PKW(P0,8), pw1[1]=PKW(P0,10), pw1); \
    VRD(5); SBAR(); GAPA(C1=__builtin_amdgcn_mfma_f32_32x32x16_bf16(kf[3],qr[1],C1,0,0,0),   P0[14],P0[15],P1[0],P1[1],   pw1[2]=PKW(P0,12),pw1[3]=PKW(P0,14), pw1); \
    VRD(2); SBAR(); GAPA(C0=__builtin_amdgcn_mfma_f32_32x32x16_bf16(kf[4],qr[2],C0,0,0,0),   P1[2],P1[3],P1[4],P1[5],     pw2[0]=PKW(P1,0), pw2[1]=PKW(P1,2), pw2); \
    VRD(6); SBAR(); GAPA(C1=__builtin_amdgcn_mfma_f32_32x32x16_bf16(kf[5],qr[2],C1,0,0,0),   P1[6],P1[7],P1[8],P1[9],     pw2[2]=PKW(P1,4), pw2[3]=PKW(P1,6), pw2); \
    VRD(3); SBAR(); GAPA(C0=__builtin_amdgcn_mfma_f32_32x32x16_bf16(kf[6],qr[3],C0,0,0,0),   P1[10],P1[11],P1[12],P1[13], pw3[0]=PKW(P1,8), pw3[1]=PKW(P1,10), pw3); \
    VRD(7); SBAR(); GAPA(C1=__builtin_amdgcn_mfma_f32_32x32x16_bf16(kf[7],qr[3],C1,0,0,0),   P1[14],P1[15],0.f,0.f,       pw3[2]=PKW(P1,12),pw3[3]=PKW(P1,14), pw3); \
    l_reg+=sacc; \
    if(GK){DMA_K((t)+3,sl_cur);} if(GV){DMA_V((t)+1,sl_next);} \
    CMASK(C0,C1,t); \
    resc=false; \
    if(chk_){ float a=MX3(C0[0],C0[1],C1[0]),b=MX3(C0[2],C0[3],C1[1]); a=MX3(a,C1[2],C1[3]); \
      _Pragma("unroll") for(int r=4;r<16;r+=4){a=MX3(a,C0[r],C0[r+1]);b=MX3(b,C0[r+2],C0[r+3]);a=MX3(a,C1[r],C1[r+1]);b=MX3(b,C1[r+2],C1[r+3]);} \
      float rm=__builtin_fmaxf(a,b); { auto rr=__builtin_amdgcn_permlane32_swap(__float_as_uint(rm),__float_as_uint(rm),false,false); rm=__builtin_fmaxf(__uint_as_float(rr[0]),__uint_as_float(rr[1])); } \
      if(__builtin_expect(__any(rm>(float)THRL),0)){ const float dl=__builtin_fmaxf(rm,0.f); mhat+=dl; \
        _Pragma("unroll") for(int r=0;r<16;++r){C0[r]-=dl;C1[r]-=dl;} \
        const float f=__builtin_amdgcn_exp2f(-dl); l_reg*=f; if(hi==0)wsf[r32]=f; resc=true; } } \
    const lds_f32* const bcp_=cl3t+((t)+1)*KVBLK+4*hi; const float bbs_=cli-mhat; \
    SBAR(); \
    GAPB(o[0]=__builtin_amdgcn_mfma_f32_32x32x16_bf16(PAF(0),VFR(0),o[0],0,0,0), C0,0, GF,P0,0); \
    GAPB(o[1]=__builtin_amdgcn_mfma_f32_32x32x16_bf16(PAF(0),VFR(4),o[1],0,0,0), C0,4, GF,P0,8); \
    KRD(GL,0); GAPB(o[0]=__builtin_amdgcn_mfma_f32_32x32x16_bf16(PAF(1),VFR(1),o[0],0,0,0), C0,8, GF,P0,16); \
    KRD(GL,1); GAPB(o[1]=__builtin_amdgcn_mfma_f32_32x32x16_bf16(PAF(1),VFR(5),o[1],0,0,0), C0,12, GF,P0,24); \
    KRD(GL,2); GAPB(o[0]=__builtin_amdgcn_mfma_f32_32x32x16_bf16(PAF(2),VFR(2),o[0],0,0,0), C1,0, GF,P1,32); \
    KRD(GL,3); GAPB(o[1]=__builtin_amdgcn_mfma_f32_32x32x16_bf16(PAF(2),VFR(6),o[1],0,0,0), C1,4, GF,P1,40); \
    GAPB(o[0]=__builtin_amdgcn_mfma_f32_32x32x16_bf16(PAF(3),VFR(3),o[0],0,0,0), C1,8, GF,P1,48); \
    GAPB(o[1]=__builtin_amdgcn_mfma_f32_32x32x16_bf16(PAF(3),VFR(7),o[1],0,0,0), C1,12, GF,P1,56); \
    }while(0)
  int t=1;
  #undef CMASK
  #define CMASK(P0,P1,t) do{}while(0)
  for(;t+5<NT;t+=2){
    STEP(pB0,pB1,pA0,pA1,t,true,true,true,true);     WAIT_BAR(2); RESC(); ROT();
    STEP(pA0,pA1,pB0,pB1,t+1,true,true,true,true);   WAIT_BAR(2); RESC(); ROT();
  }
  #undef CMASK
  #define CMASK(P0,P1,t) do{int jb_=(t)-(NT-4); if(jb_>=0)cmask(P0,P1,jb_,qrel,hi);}while(0)
  #define ENDW(tt) do{ if((tt)+3<NT){WAIT_BAR(2);} else if((tt)+2<NT){WAIT_BAR(1);} else {WAIT_BAR(0);} }while(0)
  for(;t+1<NT;t+=2){
    STEP(pB0,pB1,pA0,pA1,t,(t+3<NT),(t+1<NT),(t+1<NT),true);       ENDW(t);   RESC(); ROT();
    STEP(pA0,pA1,pB0,pB1,t+1,(t+4<NT),(t+2<NT),(t+2<NT),true);     ENDW(t+1); RESC(); ROT();
  }
  STEP(pB0,pB1,pA0,pA1,NT-1,false,false,false,false); RESC();
  { float sacc=pB0[0]+pB0[1]; _Pragma("unroll") for(int r=2;r<16;++r)sacc+=pB0[r]; _Pragma("unroll") for(int r=0;r<16;++r)sacc+=pB1[r]; l_reg+=sacc;
    pw0=(u32x4){PKW(pB0,0),PKW(pB0,2),PKW(pB0,4),PKW(pB0,6)};pw1=(u32x4){PKW(pB0,8),PKW(pB0,10),PKW(pB0,12),PKW(pB0,14)};pw2=(u32x4){PKW(pB1,0),PKW(pB1,2),PKW(pB1,4),PKW(pB1,6)};pw3=(u32x4){PKW(pB1,8),PKW(pB1,10),PKW(pB1,12),PKW(pB1,14)};
    SBAR(); pv(o,vb0+sl_cur,PAF(0),PAF(1),PAF(2),PAF(3)); }
  #undef PKW
  #undef PAF
  #undef VFR
  #undef PIN
  #undef MX3
  #undef GAPA
  #undef GAPB
  #undef EX
  #undef VRD
  #undef KRD
  #undef STEP
  #undef ENDW
  {auto rr=__builtin_amdgcn_permlane32_swap(__float_as_uint(l_reg),__float_as_uint(l_reg),false,false);l_reg=__uint_as_float(rr[0])+__uint_as_float(rr[1]);}
  if(hi==0)wsf[32+r32]=l_reg;asm volatile("s_waitcnt lgkmcnt(0)":::"memory");
  float rli[16];
  #pragma unroll
  for(int r=0;r<16;++r)rli[r]=__builtin_amdgcn_rcpf(wsf[32+crow(r,hi)]);
  bf16*Ow=O+(rowbase+q0+wid*QBLK)*DM+h*D;
  { bf16*stg=(bf16*)(shm+LDS_OST)+wid*2048;
    #pragma unroll
    for(int r=0;r<16;++r){const int orow=crow(r,hi);
      #pragma unroll
      for(int d0=0;d0<2;++d0)stg[orow*64+d0*32+r32]=__float2bfloat16(o[d0][r]*rli[r]);}
    asm volatile("s_waitcnt lgkmcnt(0)":::"memory");
    #pragma unroll
    for(int i=0;i<4;++i){const int row=i*8+(lane>>3),ch=lane&7; const u32x4 v=*(const u32x4*)(stg+row*64+ch*8); ATTN_STORE16(Ow+(long)row*DM+ch*8,v);} }
  asm volatile("s_waitcnt lgkmcnt(0)\n\ts_barrier":::"memory");
  #undef DMA_K
  #undef DMA_V
  #undef CMASK
  #undef START
  #undef RESC
  #undef ROT
  #undef BIASFILL
}
constexpr int ATTN_LDS_BYTES=LDS_BYTES;
struct AttnTensors { const bf16* Q; const bf16* K; const bf16* V; bf16* O; const float* CL; const float* GQ; const float* GK; };
struct AttnUnit { int bh; int qb; };
struct StaticOrder {
  int vcu,G;
  __device__ __forceinline__ explicit StaticOrder(int grid,int block):vcu((grid%8==0)?(block%8)*(grid/8)+block/8:block),G(grid){}
  __device__ __forceinline__ bool next(int i,AttnUnit&u)const{ const int p=vcu+G*(i>>1); if(p>=BATCH*NHEAD*NQB/2)return false; const int s=p&15; u.bh=p>>4; u.qb=(i&1)?31-s:s; return true; }
  __device__ __forceinline__ void a_ready(const AttnUnit&)const{}
  __device__ __forceinline__ void done(const AttnUnit&)const{}
};
template<class Sched,int THRL=16> __device__ __forceinline__ void attn_phase(char*lds,const AttnTensors&T,const Sched&S){
  AttnUnit u;
  for(int i=0;S.next(i,u);++i){ S.a_ready(u); attn_unit<THRL>(u.bh/NHEAD,u.bh%NHEAD,u.qb,T.Q,T.K,T.V,T.O,T.CL,T.GQ,T.GK,lds); S.done(u); }
}
template<int THRL=16> __device__ __forceinline__ void attn_phase_dyn(char*lds,const AttnTensors&T,unsigned*cnt,volatile __attribute__((address_space(3))) int*word,int myq){
  for(;;){
    if(threadIdx.x==0){ int got=-1;
      for(int k=0;k<8&&got<0;++k){ const int q=(myq+k)&7; const unsigned idx=__hip_atomic_fetch_add(cnt+64*q,1u,__ATOMIC_RELAXED,__HIP_MEMORY_SCOPE_AGENT); if(idx<64u)got=q*64+(int)idx; }
      *word=got; }
    __syncthreads();
    const int j=__builtin_amdgcn_readfirstlane(*word);
    if(j<0)break;
    const int q=j>>6,k=j&63,bh=2*q+(k&1),qb=31-(k>>1);
    attn_unit<THRL>(bh/NHEAD,bh%NHEAD,qb,T.Q,T.K,T.V,T.O,T.CL,T.GQ,T.GK,lds);
  }
  __syncthreads();
}
#undef SBAR
#undef WAIT_BAR
}
#include <hip/hip_cooperative_groups.h>
namespace cg = cooperative_groups;
constexpr int NWAVES = 8;
#ifndef REP_P0
#define REP_P0 1
#endif
#ifndef REP_T
#define REP_T 1
#endif
#ifndef REP_P1
#define REP_P1 1
#endif
#ifndef REP_ATT
#define REP_ATT 1
#endif
#ifndef REP_GATES
#define REP_GATES 1
#endif
#ifndef REP_P7F
#define REP_P7F 1
#endif
#ifndef REP_I3
#define REP_I3 1
#endif
#ifndef REP_P5
#define REP_P5 1
#endif
#ifndef PG8_ALIGN1
#define PG8_ALIGN1 PG8_ALIGN
#endif
#ifndef GATE_TAKE
#define GATE_TAKE 2
#endif
#ifndef REP_P6
#define REP_P6 1
#endif
constexpr int BATCH = 2, T = 8192, D = 1024, M = BATCH * T, DEPTH = 2;
constexpr int CC = 512, CW = 31, NH = 8, FF = 2816, INC = 4616, NIN = 19 * 256;
constexpr size_t MiB = 1u << 20;
constexpr size_t W_STRIDE = 32 * MiB, W_IN = 0, W_C = 10 * MiB, W_A = 11 * MiB, W_O = 12 * MiB, W_F = 14 * MiB, W_D = 26 * MiB;
constexpr size_t WS_XB = 64 * MiB, WS_GA = 96 * MiB, WS_GB = 128 * MiB, WS_Q = 160 * MiB, WS_K = 176 * MiB, WS_V = 192 * MiB, WS_G = 208 * MiB, WS_AC = 224 * MiB,
                 WS_SS = 240 * MiB, WS_LF = 241 * MiB, WS_CL = 242 * MiB, WS_CTL = 243 * MiB, WS_END = 244 * MiB;
constexpr size_t WS_HB = 96 * MiB;
static_assert(WS_HB + (size_t)M * FF * 2 <= WS_V && W_F + (size_t)2 * FF * D * 2 <= W_D && W_D + (size_t)D * FF * 2 <= W_STRIDE && (size_t)NIN * D * 2 <= W_C, "d_ws map");
constexpr int RING_BYTES = 131072, LDS_BYTES = 135168, LDS_BARST = RING_BYTES + 64;
constexpr size_t CTL_ZERO_BYTES = 65536;

#define LAS __attribute__((address_space(3)))
typedef unsigned short bf16;
typedef unsigned v4u __attribute__((ext_vector_type(4)));
typedef float f32x4 __attribute__((ext_vector_type(4)));
typedef float f32x2 __attribute__((ext_vector_type(2)));
#define LDS_WAIT() asm volatile("s_waitcnt lgkmcnt(0)" ::: "memory")
__device__ __forceinline__ unsigned f2bf(float f) { unsigned u = __builtin_bit_cast(unsigned, f); return (u + 0x7fffu + ((u >> 16) & 1u)) >> 16; }
__device__ __forceinline__ unsigned pk2(float lo, float hi) { return f2bf(lo) | (f2bf(hi) << 16); }
__device__ __forceinline__ float wave_sum(float v) {
#pragma unroll
    for (int o = 1; o < 64; o <<= 1) v += __shfl_xor(v, o);
    return v;
}
__device__ __forceinline__ void tr_item(const float* W, int ldw, int K, bf16* WT, int kb, int orow0, int src0, int valid, const float* gk, LAS float* scr, int lane) {
    const int k0 = 64 * kb, c = lane & 31;
    float v[32], gsc[32];
    const bool ok = c < valid;
#pragma unroll
    for (int i = 0; i < 32; ++i) { const int kk = 2 * i + (lane >> 5); v[i] = ok ? __builtin_nontemporal_load(W + (size_t)(k0 + kk) * ldw + src0 + c) : 0.f;     gsc[i] = gk ? gk[k0 + kk] : 1.0f; }
#pragma unroll
    for (int i = 0; i < 32; ++i) { const int kk = 2 * i + (lane >> 5); scr[kk * 33 + c] = v[i] * gsc[i]; }
    LDS_WAIT(); asm volatile("" ::: "memory");
    const int ch = lane & 7;
#pragma unroll
    for (int j = 0; j < 4; ++j) { const int n = (lane >> 3) + 8 * j; const LAS float* s = scr + (8 * ch) * 33 + n;
        v4u o; o.x = pk2(s[0 * 33], s[1 * 33]); o.y = pk2(s[2 * 33], s[3 * 33]); o.z = pk2(s[4 * 33], s[5 * 33]); o.w = pk2(s[6 * 33], s[7 * 33]);
        *(v4u*)(WT + (size_t)(orow0 + n) * K + k0 + 8 * ch) = o; }
    LDS_WAIT(); asm volatile("" ::: "memory");
}
__device__ __forceinline__ int src_in(int ob, int& valid) {
    const int p = ob >> 3, sub = ob & 7; valid = 32;
    if (p < 4) return sub < 4 ? 128 * p + 32 * sub : 512 + 128 * p + 32 * (sub - 4);
    if (p < 8) { const int base = p < 6 ? 1024 : 1536, hh = 4 * (p & 1) + (sub & 3), bj = sub >> 2; return base + hh * 64 + 32 * bj; }
    if (p < 10) return 2048 + 256 * (p - 8) + 32 * sub;
    if (p == 10) { if (sub == 0) { valid = 8; return 2560; } valid = 0; return 0; }
    if (p < 15) return 2568 + 256 * (p - 11) + 32 * sub;
    return 3592 + 256 * (p - 15) + 32 * sub;
}
__device__ __forceinline__ int src_ffn(int ob) { const int p = ob >> 3, sub = ob & 7; return sub < 4 ? 128 * p + 32 * sub : FF + 128 * p + 32 * (sub - 4); }

#define XB_TMO      128
#define XB_XCNT(j)  (256  + 64 * (j))
#define XB_XSUB(j)  (1280 + 64 * (j))
#define XB_XGEN(j)  (2304 + 64 * (j))
#define XB_TOP      3328
#define XB_TOPGEN   3392
#define XCD_BAR_WORDS 3456
#define XB_SPIN_CAP (1u << 18)

__device__ __forceinline__ unsigned xb_ld(unsigned* p)              { return __hip_atomic_load(p, __ATOMIC_RELAXED, __HIP_MEMORY_SCOPE_AGENT); }
__device__ __forceinline__ unsigned xb_add(unsigned* p, unsigned v) { return __hip_atomic_fetch_add(p, v, __ATOMIC_RELAXED, __HIP_MEMORY_SCOPE_AGENT); }
__device__ __forceinline__ unsigned xb_xcc_id() { return (unsigned)__builtin_amdgcn_s_getreg((3 << 11) | 20) & 0xFu; }
#define XB_SPIN(cond, bar) do { unsigned _sp = 0; while (cond) { __builtin_amdgcn_s_sleep(1); \
    if ((++_sp & 255u) == 0u) { if (xb_ld(&(bar)[XB_TMO])) break; if (_sp > XB_SPIN_CAP) { atomicAdd(&(bar)[XB_TMO], 1u); break; } } } } while (0)

struct XcdBarrier {
    unsigned* bar; unsigned x;
    volatile LAS unsigned* st;
};

__device__ __forceinline__ XcdBarrier xcd_barrier_post(unsigned* bar, volatile LAS unsigned* st) {
    XcdBarrier b; b.bar = bar; b.x = xb_xcc_id(); b.st = st;
    if (threadIdx.x == 0) (void)xb_add(&bar[XB_XCNT(b.x)], 1u);
    return b;
}
__device__ __forceinline__ void xcd_barrier_complete(unsigned* bar, unsigned x, unsigned& nloc, unsigned& nx) {
    const unsigned G = gridDim.x * gridDim.y * gridDim.z;
    unsigned sum, cnt, mine, sp = 0u;
    for (;;) {
        sum = 0u; cnt = 0u; mine = 0u;
#pragma unroll
        for (unsigned j = 0; j < 16; ++j) { const unsigned c = xb_ld(&bar[XB_XCNT(j)]); sum += c; cnt += (c > 0u) ? 1u : 0u; mine = (j == x) ? c : mine; }
        if (sum == G) break;
        __builtin_amdgcn_s_sleep(1);
        if ((++sp & 255u) == 0u) { if (xb_ld(&bar[XB_TMO])) break; if (sp > XB_SPIN_CAP) { atomicAdd(&bar[XB_TMO], 1u); break; } }
    }
    nloc = mine > 0u ? mine : 1u; nx = cnt > 0u ? cnt : 1u;
}

__device__ __forceinline__ void xcd_barrier(const XcdBarrier& b) {
    asm volatile("s_waitcnt vmcnt(0)" ::: "memory");
    __syncthreads();
    if (threadIdx.x == 0) {
        unsigned* bar = b.bar;
        __builtin_amdgcn_s_waitcnt(0);
        unsigned nloc = b.st[0], nx = b.st[1];
        if (nloc == 0u) { xcd_barrier_complete(bar, b.x, nloc, nx); b.st[0] = nloc; b.st[1] = nx; }
        const unsigned old = xb_add(&bar[XB_XSUB(b.x)], 1u);
        const unsigned gen = old / nloc;
        if (old + 1u == (gen + 1u) * nloc) {
            __builtin_amdgcn_fence(__ATOMIC_RELEASE, "agent");
            asm volatile("s_waitcnt vmcnt(0)" ::: "memory");
            const unsigned og = xb_add(&bar[XB_TOP], 1u);
            const unsigned tg = og / nx;
            if (og + 1u == (tg + 1u) * nx) xb_add(&bar[XB_TOPGEN], 1u);
            else XB_SPIN(xb_ld(&bar[XB_TOPGEN]) == tg, bar);
            __builtin_amdgcn_fence(__ATOMIC_ACQUIRE, "agent");
            xb_add(&bar[XB_XGEN(b.x)], 1u);
            asm volatile("s_waitcnt vmcnt(0)" ::: "memory");
        } else {
            XB_SPIN(xb_ld(&bar[XB_XGEN(b.x)]) == gen, bar);
            __builtin_amdgcn_fence(__ATOMIC_ACQUIRE, "agent");
            asm volatile("s_waitcnt vmcnt(0)" ::: "memory");
        }
    }
    __syncthreads();
}

struct Args { const float* in[16]; float* out; unsigned char* ws; };

__device__ __forceinline__ void scan_seq(LAS unsigned char* lds, int tid, const float* lf, float* cl) {
    const int lane = tid & 63, wave = tid >> 6;
    f32x4 v[4];
#pragma unroll
    for (int j = 0; j < 4; ++j) v[j] = *(const f32x4*)(lf + tid * 16 + 4 * j);
    float run = 0.f;
#pragma unroll
    for (int j = 0; j < 4; ++j)
#pragma unroll
        for (int e = 0; e < 4; ++e) { run += v[j][e]; v[j][e] = run; }
    float inc = run;
#pragma unroll
    for (int o = 1; o < 64; o <<= 1) { const float y = __shfl_up(inc, o); if (lane >= o) inc += y; }
    LAS float* wt = (LAS float*)lds;
    if (lane == 63) wt[wave] = inc;
    __syncthreads();
    float off = inc - run;
    for (int w = 0; w < wave; ++w) off += wt[w];
#pragma unroll
    for (int j = 0; j < 4; ++j) { *(f32x4*)(cl + tid * 16 + 4 * j) = (v[j] + off) * 1.4426950408889634f; }
    __syncthreads();
}

#define XB_LSUB(j)  (3584 + 64 * (j))
#define XB_LGEN(j)  (4608 + 64 * (j))
#define XB_RMAXA(r) (5696 + 64 * (r))
#define XB_RMAXB(r) (6208 + 64 * (r))
__device__ __forceinline__ void xcd_local_barrier(const XcdBarrier& b, unsigned nloc) {
    asm volatile("s_waitcnt vmcnt(0)" ::: "memory");
    __syncthreads();
    if (threadIdx.x == 0) {
        unsigned* bar = b.bar;
        const unsigned old = xb_add(&bar[XB_LSUB(b.x)], 1u);
        const unsigned gen = old / nloc;
        if (old + 1u == (gen + 1u) * nloc) xb_add(&bar[XB_LGEN(b.x)], 1u);
        else XB_SPIN(xb_ld(&bar[XB_LGEN(b.x)]) == gen, bar);
        __builtin_amdgcn_fence(__ATOMIC_ACQUIRE, "agent");
        asm volatile("s_waitcnt vmcnt(0)" ::: "memory");
    }
    __syncthreads();
}
struct OneUnit { int q, k0, n;
    __device__ __forceinline__ bool next(int i, pg8::Unit& u) const { if (i >= n) return false; const int k = k0 + i; u.pm = 8 * q + (k & 7); u.pn = k >> 3; return true; }
    __device__ __forceinline__ void a_ready(const pg8::Unit&) const {}
    __device__ __forceinline__ void done(const pg8::Unit&) const {} };
__device__ __forceinline__ int claim_unit(unsigned* cnt, int myq, int per_q, volatile LAS int* word, unsigned take = 1u) {
    if (threadIdx.x == 0) { int got = -1;
        for (int k = 0; k < 8 && got < 0; ++k) { const int q = (myq + k) & 7; const unsigned idx = __hip_atomic_fetch_add(cnt + 64 * q, take, __ATOMIC_RELAXED, __HIP_MEMORY_SCOPE_AGENT); if (idx < (unsigned)per_q) got = q * per_q + (int)idx; }
        *word = got; }
    __syncthreads();
    const int j = __builtin_amdgcn_readfirstlane(*word);
    __syncthreads();
    return j;
}
__device__ __forceinline__ void conv_phase(LAS unsigned char* lds, unsigned* cnt, int myq, volatile LAS int* word, int tid, const bf16* Gin, const float* wdw, const float* bdw, const float* gln, const float* bln, bf16* AC) {
    LAS unsigned* lin = (LAS unsigned*)lds;
    LAS float* lout = (LAS float*)(lds + 63488);
    const int lane = tid & 63, wave = tid >> 6, cp = tid & 255, th = tid >> 8;
    f32x2 wv[31];
#pragma unroll
    for (int k = 0; k < 31; ++k) wv[k] = *(const f32x2*)(wdw + k * 512 + 2 * cp);
    const f32x2 bb = *(const f32x2*)(bdw + 2 * cp);
    const f32x4 g0 = *(const f32x4*)(gln + 8 * lane), g1 = *(const f32x4*)(gln + 8 * lane + 4), b0 = *(const f32x4*)(bln + 8 * lane), b1 = *(const f32x4*)(bln + 8 * lane + 4);
    for (;;) {
        const int pass = claim_unit(cnt, myq, (M / 32) / 8, word); if (pass < 0) break;
        const int m0 = pass * 32, tb = m0 & (T - 1);
        for (int c = tid; c < 62 * 64; c += NWAVES * 64) { const int r = c >> 6, ch = c & 63; v4u v = (v4u){0u, 0u, 0u, 0u};
            if (tb - 30 + r >= 0) v = *(const v4u*)(Gin + (size_t)(m0 - 30 + r) * 512 + ch * 8);
            *(LAS v4u*)(lin + r * 256 + ch * 4) = v; }
        __syncthreads();
        f32x2 av[16];
#pragma unroll
        for (int o = 0; o < 16; ++o) av[o] = bb;
#pragma unroll
        for (int r = 0; r < 46; ++r) { const unsigned v = lin[(16 * th + r) * 256 + cp]; const f32x2 xv = (f32x2){__uint_as_float(v << 16), __uint_as_float(v & 0xffff0000u)};
#pragma unroll
            for (int o = 0; o < 16; ++o) { const int k = r - o; if (k >= 0 && k < 31) av[o] = __builtin_elementwise_fma(wv[k], xv, av[o]); } }
#pragma unroll
        for (int o = 0; o < 16; ++o) *(LAS f32x2*)(lout + (16 * th + o) * 512 + 2 * cp) = av[o];
        __syncthreads();
#pragma unroll
        for (int i = 0; i < 4; ++i) { const int tok = 4 * wave + i;
            f32x4 x0 = *(const LAS f32x4*)(lout + tok * 512 + 8 * lane), x1 = *(const LAS f32x4*)(lout + tok * 512 + 8 * lane + 4);
            const float mean = wave_sum(((x0[0] + x0[1]) + (x0[2] + x0[3])) + ((x1[0] + x1[1]) + (x1[2] + x1[3]))) * (1.0f / 512.0f);
            x0 = x0 - mean; x1 = x1 - mean;
            const float var = wave_sum(((x0[0] * x0[0] + x0[1] * x0[1]) + (x0[2] * x0[2] + x0[3] * x0[3])) + ((x1[0] * x1[0] + x1[1] * x1[1]) + (x1[2] * x1[2] + x1[3] * x1[3]))) * (1.0f / 512.0f);
            const float rstd = __builtin_amdgcn_rsqf(var + 1e-6f);
            x0 = x0 * rstd * g0 + b0; x1 = x1 * rstd * g1 + b1;
#pragma unroll
            for (int e = 0; e < 4; ++e) { x0[e] = x0[e] * pg8::sigm(x0[e]); x1[e] = x1[e] * pg8::sigm(x1[e]); }
            *(pg8::u32x4*)(AC + (size_t)(m0 + tok) * 512 + 8 * lane) = pg8::pack8(x0, x1); }
        __syncthreads();
    }
}
constexpr int I_IN = (D / 64) * (NIN / 32), I_C = (CC / 64) * (D / 32), I_O = (D / 64) * (D / 32), I_F = (D / 64) * (2 * FF / 32), I_D = (FF / 64) * (D / 32);
constexpr int I_L = I_IN + 2 * I_C + I_O + I_F + I_D, W_ITEMS = I_L;
__device__ __forceinline__ void weight_item(const Args& args, unsigned char* ws, int it, LAS float* scr, int lane) {
            const int l = it / I_L; int r = it % I_L; unsigned char* wl = ws + (size_t)l * W_STRIDE;
            if (r < I_IN) { const int nblk = NIN / 32, kb = r / nblk, ob = r % nblk; int valid; const int s0 = src_in(ob, valid);
                tr_item(args.in[2] + (size_t)l * D * INC, INC, D, (bf16*)(wl + W_IN), kb, 32 * ob, s0, valid, args.in[1] + l * D, scr, lane); return; } r -= I_IN;
            if (r < I_C) { const int nblk = D / 32, kb = r / nblk, ob = r % nblk;
                tr_item(args.in[8] + (size_t)l * CC * D, D, CC, (bf16*)(wl + W_C), kb, 32 * ob, 32 * ob, 32, nullptr, scr, lane); return; } r -= I_C;
            if (r < I_C) { const int nblk = D / 32, kb = r / nblk, ob = r % nblk;
                tr_item(args.in[11] + (size_t)l * CC * D, D, CC, (bf16*)(wl + W_A), kb, 32 * ob, 32 * ob, 32, nullptr, scr, lane); return; } r -= I_C;
            if (r < I_O) { const int nblk = D / 32, kb = r / nblk, ob = r % nblk;
                tr_item(args.in[12] + (size_t)l * D * D, D, D, (bf16*)(wl + W_O), kb, 32 * ob, 32 * ob, 32, nullptr, scr, lane); return; } r -= I_O;
            if (r < I_F) { const int nblk = 2 * FF / 32, kb = r / nblk, ob = r % nblk;
                tr_item(args.in[14] + (size_t)l * D * 2 * FF, 2 * FF, D, (bf16*)(wl + W_F), kb, 32 * ob, src_ffn(ob), 32, args.in[13] + l * D, scr, lane); return; } r -= I_F;
            { const int nblk = D / 32, kb = r / nblk, ob = r % nblk;
                tr_item(args.in[15] + (size_t)l * FF * D, D, FF, (bf16*)(wl + W_D), kb, 32 * ob, 32 * ob, 32, nullptr, scr, lane); }
}

__global__ void __launch_bounds__(NWAVES * 64, 2) fwd_kernel(Args args) {
    extern __shared__ __attribute__((aligned(16))) unsigned char lds_raw[];
    cg::grid_group grid = cg::this_grid();
    LAS unsigned char* lds = (LAS unsigned char*)lds_raw;
    if (threadIdx.x < 2) ((volatile LAS unsigned*)(lds + LDS_BARST))[threadIdx.x] = 0u;
    __syncthreads();
    const XcdBarrier bar = xcd_barrier_post((unsigned*)(args.ws + WS_CTL), (volatile LAS unsigned*)(lds + LDS_BARST));
    if (threadIdx.x == 0) { unsigned* cw = (unsigned*)(args.ws + WS_CTL); __hip_atomic_fetch_max(cw + XB_RMAXA(blockIdx.x & 7u), bar.x + 1u, __ATOMIC_RELAXED, __HIP_MEMORY_SCOPE_AGENT); __hip_atomic_fetch_max(cw + XB_RMAXB(blockIdx.x & 7u), 16u - bar.x, __ATOMIC_RELAXED, __HIP_MEMORY_SCOPE_AGENT); }
    if (args.ws == nullptr) grid.sync();
#define GRID_SYNC() xcd_barrier(bar)
    const int tid = threadIdx.x, lane = tid & 63, wave = __builtin_amdgcn_readfirstlane(tid >> 6);
    const int G = gridDim.x, bx = blockIdx.x, vcu = (G % 8 == 0) ? (bx % 8) * (G / 8) + bx / 8 : bx;
    unsigned char* ws = args.ws;
    const float* x = args.in[0]; float* out = args.out;
    bf16* XB = (bf16*)(ws + WS_XB); bf16* GA = (bf16*)(ws + WS_GA); bf16* GB = (bf16*)(ws + WS_GB); bf16* Qb = (bf16*)(ws + WS_Q); bf16* Kb = (bf16*)(ws + WS_K); bf16* Vb = (bf16*)(ws + WS_V);
    bf16* Gb = (bf16*)(ws + WS_G); bf16* AC = (bf16*)(ws + WS_AC); bf16* HB = (bf16*)(ws + WS_HB);
    float* SS = (float*)(ws + WS_SS); float* LF = (float*)(ws + WS_LF); float* CL = (float*)(ws + WS_CL);

    for (int rep0 = 0; rep0 < REP_P0; ++rep0) {
        int tidP = threadIdx.x; asm volatile("" : "+v"(tidP)); const int lane = tidP & 63;
        LAS float* scr = (LAS float*)(lds + wave * 16384);
        const int gw = vcu * NWAVES + wave, NGW = G * NWAVES;
        const bool split = (G == 256);
        for (int it = gw; it < (split ? W_ITEMS : DEPTH * W_ITEMS); it += NGW) weight_item(args, ws, it, scr, lane);
        for (int m0 = gw; m0 < M; m0 += 4 * NGW) {
            f32x4 v[4][4];
#pragma unroll
            for (int r = 0; r < 4; ++r) { const int m = m0 + r * NGW; if (m < M) { const f32x4* xr = (const f32x4*)(x + (size_t)m * D) + lane;
#pragma unroll
                for (int j = 0; j < 4; ++j) v[r][j] = __builtin_nontemporal_load(xr + 64 * j); } }
#pragma unroll
            for (int r = 0; r < 4; ++r) { const int m = m0 + r * NGW; if (m < M) { float s = 0.f;
#pragma unroll
                for (int j = 0; j < 4; ++j) s += (v[r][j][0] * v[r][j][0] + v[r][j][1] * v[r][j][1]) + (v[r][j][2] * v[r][j][2] + v[r][j][3] * v[r][j][3]);
                s = wave_sum(s);
                unsigned long long* o8 = (unsigned long long*)(XB + (size_t)m * D) + lane;
#pragma unroll
                for (int j = 0; j < 4; ++j) o8[64 * j] = (unsigned long long)pk2(v[r][j][0], v[r][j][1]) | ((unsigned long long)pk2(v[r][j][2], v[r][j][3]) << 32);
                if (lane < 16) SS[(size_t)m * 16 + lane] = lane == 0 ? s : 0.f; } }
        }
    }
    GRID_SYNC();
    if (threadIdx.x == 0) { unsigned* cw = (unsigned*)(args.ws + WS_CTL); int bad = (gridDim.x != 256u);
        for (unsigned r = 0; r < 8; ++r) bad |= (xb_ld(cw + XB_RMAXA(r)) + xb_ld(cw + XB_RMAXB(r)) != 17u);
        for (unsigned j = 0; j < 16; ++j) { const unsigned c = xb_ld(cw + XB_XCNT(j)); bad |= (c != 0u && c != 32u); }
        *(volatile LAS int*)(lds + LDS_BARST + 48) = bad; }
    __syncthreads();
    const bool aligned = __builtin_amdgcn_readfirstlane(*(volatile LAS int*)(lds + LDS_BARST + 48)) == 0;
#define SEAM_LOCAL() do { if (aligned) xcd_local_barrier(bar, 32u); else xcd_barrier(bar); } while (0)
#ifdef PROBE_ALIGNED
    if (!aligned) for (int eb = 0; eb < 20; ++eb) GRID_SYNC();
#endif

    for (int l = 0; l < DEPTH; ++l) {
        unsigned char* wl = ws + (size_t)l * W_STRIDE;
        for (int rep1 = 0; rep1 < REP_P1; ++rep1) {
            pg8::Gemm g{XB, (const bf16*)(wl + W_IN), M, 11 * 256, D}; pg8::StaticOrder S; S.init(M, 11 * 256, G, bx);
            pg8::EpiInProj E{SS, Gb, Qb, Kb, Vb, LF, args.in[9] + l * 64, args.in[10] + l * 64, args.in[3] + l * NH, attn_body::C2};
            pg8::gemm_phase<pg8::EpiInProj, pg8::StaticOrder, PG8_ALIGN, PG8_SP2>(lds, g, S, E);
        }
        for (int stage = 0; stage < 2; ++stage) {
            if (stage == 1) {
                GRID_SYNC();
                const attn_body::AttnTensors AT{(const attn_body::bf16*)Qb, (const attn_body::bf16*)Kb, (const attn_body::bf16*)Vb, (attn_body::bf16*)Qb, LF, args.in[9] + l * 64, args.in[10] + l * 64};
                attn_body::attn_phase_dyn((char*)lds_raw, AT, (unsigned*)(args.ws + WS_CTL) + 8192 + l * 1024, (volatile LAS int*)(lds + LDS_BARST + 32), (int)bar.x & 7);
            }
#ifndef STAGE0_GATES
#define STAGE0_GATES 1
#endif
            int budget = stage == 0 ? ((G == 256 && bx >= 192) ? STAGE0_GATES : 0) : (1 << 30);
            while (budget-- > 0) {
                const unsigned take = stage == 0 ? 1u : (unsigned)GATE_TAKE;
                const int j = claim_unit((unsigned*)(args.ws + WS_CTL) + 8192 + 512 + l * 1024, (int)bar.x & 7, 64, (volatile LAS int*)(lds + LDS_BARST + 32), take);
                if (j < 0) break;
                const int q = j >> 6, k = j & 63, nu = (64 - k) < (int)take ? (64 - k) : (int)take;
                pg8::Gemm g{XB, (const bf16*)(wl + W_IN) + (size_t)11 * 256 * D, M, 8 * 256, D}; const OneUnit S{q, k, nu};
                pg8::EpiGateSig E{SS, GA, GB};
                pg8::gemm_phase<pg8::EpiGateSig, OneUnit, PG8_ALIGN, PG8_SP2>(lds, g, S, E);
            }
            if (stage == 1) {
                int tidT = threadIdx.x; asm volatile("" : "+v"(tidT));
                conv_phase(lds, (unsigned*)(args.ws + WS_CTL) + 8192 + 2048 + l * 1024, (int)bar.x & 7, (volatile LAS int*)(lds + LDS_BARST + 32), tidT, Gb, args.in[4] + (size_t)l * CW * CC, args.in[5] + l * CC, args.in[6] + l * CC, args.in[7] + l * CC, AC);
            }
        }
        GRID_SYNC();
        {
            static_assert((WS_AC - WS_Q) % ((size_t)256 * CC * 2) == 0 && W_A == W_C + (size_t)D * CC * 2, "the pair order reaches O and the attn-out weights through unit indices");
            constexpr int APM_OFF = (int)((WS_AC - WS_Q) / ((size_t)256 * CC * 2));
            pg8::Gemm g{AC, (const bf16*)(wl + W_C), M, D, CC}; pg8::PairOrder S; S.s.init(M, D, G, bx); S.apm_off = APM_OFF;
            pg8::EpiGatePair E{GA, GB, APM_OFF};
            pg8::gemm_phase<pg8::EpiGatePair, pg8::PairOrder, PG8_ALIGN, PG8_SP2>(lds, g, S, E);
        }
        SEAM_LOCAL();
        {
            pg8::Gemm g{GB, (const bf16*)(wl + W_O), M, D, D}; pg8::StaticOrder S; S.init(M, D, G, bx);
            for (int rep5 = 0; rep5 < REP_P5; ++rep5) { const bool lastr = rep5 + 1 == REP_P5;
            pg8::EpiResid<false> E{out, XB, SS, lastr ? XB : (bf16*)out, lastr ? SS : out + (size_t)M * D / 2};
            pg8::gemm_phase<pg8::EpiResid<false>, pg8::StaticOrder, PG8_ALIGN1, PG8_SP2>(lds, g, S, E); }
        }
        GRID_SYNC();
        for (int rep6 = 0; rep6 < REP_P6; ++rep6) {
            pg8::Gemm g{XB, (const bf16*)(wl + W_F), M, 2 * FF, D}; pg8::StaticOrder S; S.init(M, 2 * FF, G, bx);
            pg8::EpiSwiglu E{SS, HB};
            pg8::gemm_phase<pg8::EpiSwiglu, pg8::StaticOrder, PG8_ALIGN, PG8_SP2>(lds, g, S, E);
#ifdef REP_P6_BAR
            if (rep6 + 1 < REP_P6) GRID_SYNC();
#endif
        }
        if (l == 0 && G == 256 && bx >= 128) {
            int tidW = threadIdx.x; asm volatile("" : "+v"(tidW));
            LAS float* scr = (LAS float*)(lds + wave * 16384);
            for (int it = W_ITEMS + (bx - 128) * NWAVES + wave; it < DEPTH * W_ITEMS; it += 128 * NWAVES) weight_item(args, ws, it, scr, tidW & 63);
        }
        SEAM_LOCAL();
        {
            pg8::Gemm g{HB, (const bf16*)(wl + W_D), M, D, FF}; pg8::StaticOrder S; S.init(M, D, G, bx);
            if (l + 1 < DEPTH) { pg8::EpiResid<false> E{out, XB, SS, XB, SS}; pg8::gemm_phase<pg8::EpiResid<false>, pg8::StaticOrder, PG8_ALIGN1, PG8_SP2>(lds, g, S, E); }
            else { for (int rep7 = 0; rep7 < REP_P7F; ++rep7) { pg8::EpiResid<true> E{out, XB, SS, XB, SS}; pg8::gemm_phase<pg8::EpiResid<true>, pg8::StaticOrder, PG8_ALIGN1, PG8_SP2>(lds, g, S, E); } }
        }
        if (l + 1 < DEPTH) GRID_SYNC();
#ifdef EXTRA_BARS
        for (int eb = 0; eb < EXTRA_BARS; ++eb) GRID_SYNC();
#endif
    }
}

extern "C" void kernel_launch(void* const* d_in, const int* in_sizes, int n_in, void* d_out, int out_size, void* d_ws, size_t ws_size, hipStream_t stream) {
    static int grid = 0;
    if (grid == 0) {
        if (n_in != 16 || in_sizes[0] != M * D || out_size != M * D || ws_size < WS_END) { fprintf(stderr, "kernel_launch: unexpected shapes (n_in %d, in0 %d, out %d, ws %zu)\n", n_in, n_in > 0 ? in_sizes[0] : -1, out_size, ws_size); grid = -1; return; }
        int dev = 0, cus = 0, per_cu = 0;
        if (hipGetDevice(&dev) != hipSuccess || hipDeviceGetAttribute(&cus, hipDeviceAttributeMultiprocessorCount, dev) != hipSuccess) { grid = -1; return; }
        if (hipFuncSetAttribute((const void*)fwd_kernel, hipFuncAttributeMaxDynamicSharedMemorySize, LDS_BYTES) != hipSuccess) { fprintf(stderr, "kernel_launch: hipFuncSetAttribute failed\n"); grid = -1; return; }
        if (hipOccupancyMaxActiveBlocksPerMultiprocessor(&per_cu, (const void*)fwd_kernel, NWAVES * 64, LDS_BYTES) != hipSuccess || per_cu < 1) { fprintf(stderr, "kernel_launch: occupancy query says %d\n", per_cu); per_cu = 1; }
        (void)hipGetLastError();
        grid = cus * 1;
        (void)per_cu;
    }
    if (grid < 0) return;
    if (hipMemsetAsync((char*)d_ws + WS_CTL, 0, CTL_ZERO_BYTES, stream) != hipSuccess) { fprintf(stderr, "kernel_launch: hipMemsetAsync failed\n"); return; }
    Args a{};
    for (int i = 0; i < 16; ++i) a.in[i] = (const float*)d_in[i];
    a.out = (float*)d_out; a.ws = (unsigned char*)d_ws;
    void* params[] = {&a};
    const hipError_t le = hipLaunchCooperativeKernel((const void*)fwd_kernel, dim3(grid), dim3(NWAVES * 64), params, LDS_BYTES, stream);
    if (le != hipSuccess) fprintf(stderr, "kernel_launch: cooperative launch failed: %s (grid %d)\n", hipGetErrorName(le), grid);
}
```

```cpp
#include <hip/hip_runtime.h>
#include <cstdio>
#include <cstdint>
namespace pg8 {
#define PG8_LAS __attribute__((address_space(3)))
typedef unsigned short bf16_t;
typedef short bf16x8 __attribute__((ext_vector_type(8)));
typedef float f32x4 __attribute__((ext_vector_type(4)));
typedef unsigned u32x4 __attribute__((ext_vector_type(4)));
constexpr int BM = 256, BK = 64, HALF = 128, HTB = HALF * BK * 2  , STAGE_BYTES = 8 * HTB, NXCD = 8, WGM = 8;

__host__ __device__ __forceinline__ int lds_byte(int r, int c) { const int st = (r >> 4) * 2 + (c >> 5), rr = r & 15, cc = c & 31, ob = rr * 64 + cc * 2; return st * 1024 + (ob ^ (((ob >> 9) & 1) << 5)); }
__host__ __device__ __forceinline__ void stage_rc(int b, int& R, int& C) { const int st = b / 1024, sb = b % 1024, swz = sb ^ (((sb >> 9) & 1) << 5); R = (st >> 1) * 16 + swz / 64; C = (st & 1) * 32 + (swz % 64) / 2; }
__host__ __device__ __forceinline__ int perm32(int rho) { const int n = rho >> 4, i = rho & 15; return 8 * (i >> 2) + 4 * n + (i & 3); }

struct Unit { int pm, pn; };
struct Gemm { const bf16_t* A; const bf16_t* Bt; int M, N, K; };

struct StaticOrder {
    int nM, nN, nwg, G, c;
    __host__ __device__ void init(int M, int N, int G_, int c_) { nM = M / BM; nN = N / BM; nwg = nM * nN; G = G_; c = c_; }
    __host__ __device__ bool next(int i, Unit& u) const {
        const long L = (long)i * G + c; if (L >= nwg) return false;
        int wgid = (int)L; { const int q = nwg / NXCD, r = nwg % NXCD, xcd = wgid % NXCD, off = wgid / NXCD; wgid = (xcd < r ? xcd * (q + 1) : r * (q + 1) + (xcd - r) * q) + off; }
        const int nig = WGM * nN, gid = wgid / nig, fm = gid * WGM, gsz = (nM - fm) < WGM ? (nM - fm) : WGM;
        u.pm = fm + ((wgid % nig) % gsz); u.pn = (wgid % nig) / gsz; return true;
    }
    __device__ __forceinline__ void a_ready(const Unit&) const {}
    __device__ __forceinline__ void done(const Unit&) const {}
};

typedef float f32x2cv __attribute__((ext_vector_type(2))); typedef __bf16 bf16x2cv __attribute__((ext_vector_type(2)));
__device__ __forceinline__ unsigned cvt_pk_bf16(float lo, float hi) { const f32x2cv v = {lo, hi}; const bf16x2cv b = __builtin_convertvector(v, bf16x2cv); return __builtin_bit_cast(unsigned, b); }
typedef float f32x2 __attribute__((ext_vector_type(2)));
typedef float f32x2 __attribute__((ext_vector_type(2)));
__device__ __forceinline__ float bf_lo(unsigned u) { return __uint_as_float(u << 16); }
__device__ __forceinline__ float bf_hi(unsigned u) { return __uint_as_float(u & 0xffff0000u); }
__device__ __forceinline__ float sigm(float x) { return __builtin_amdgcn_rcpf(1.0f + __expf(-x)); }
__device__ __forceinline__ u32x4 pack8(const f32x4 a, const f32x4 b) { u32x4 w; w.x = cvt_pk_bf16(a[0], a[1]); w.y = cvt_pk_bf16(a[2], a[3]); w.z = cvt_pk_bf16(b[0], b[1]); w.w = cvt_pk_bf16(b[2], b[3]); return w; }
__device__ __forceinline__ void unpack8(const u32x4 w, f32x4& a, f32x4& b) { a = (f32x4){bf_lo(w.x), bf_hi(w.x), bf_lo(w.y), bf_hi(w.y)}; b = (f32x4){bf_lo(w.z), bf_hi(w.z), bf_lo(w.w), bf_hi(w.w)}; }
__device__ __forceinline__ u32x4 ld16_nt(const bf16_t* p) { return __builtin_nontemporal_load((const u32x4*)p); }
__device__ __forceinline__ float row_inv(const float* ss, int row) {
    const f32x4* p = (const f32x4*)(ss + (size_t)row * 16);
    const f32x4 a = p[0], b = p[1], c = p[2], d = p[3];
    const float s = (((a[0] + a[1]) + (a[2] + a[3])) + ((b[0] + b[1]) + (b[2] + b[3]))) + (((c[0] + c[1]) + (c[2] + c[3])) + ((d[0] + d[1]) + (d[2] + d[3])));
    return __builtin_amdgcn_rsqf(s * (1.0f / 1024.0f) + 1e-6f);
}

struct EpiGateSig {
    static constexpr bool PERM = true, AFTER_DRAIN = false;
    const float* ss; bf16_t *GA, *GB;
    __device__ __forceinline__ void operator()(const f32x4 (&acc)[2][2][4][2], const Unit& u, int wr, int wc, int fr, int fq) const {
        const int p = u.pn; const int rowb = u.pm * BM + wr * 64 + fr;
        bf16_t* O = p < 4 ? GA : GB; const int cb = (p & 3) * 256;
#pragma unroll
        for (int ai = 0; ai < 2; ++ai)
#pragma unroll
            for (int m = 0; m < 4; ++m) { const int row = rowb + ai * HALF + m * 16; const float inv = row_inv(ss, row);
#pragma unroll
                for (int bj = 0; bj < 2; ++bj) { f32x4 o[2];
#pragma unroll
                    for (int n = 0; n < 2; ++n) { const f32x4 v = acc[ai][bj][m][n] * inv;
#pragma unroll
                        for (int e = 0; e < 4; ++e) o[n][e] = sigm(v[e]); }
                    *(u32x4*)(O + (size_t)row * 1024 + cb + bj * HALF + wc * 32 + fq * 8) = pack8(o[0], o[1]); } }
    }
};
struct EpiInProj {
    static constexpr bool PERM = true, AFTER_DRAIN = false;
    const float* ss; bf16_t *G, *Q, *K, *V; float* LF; const float *gq, *gk, *bfg; float c2;
    __device__ __forceinline__ void operator()(const f32x4 (&acc)[2][2][4][2], const Unit& u, int wr, int wc, int fr, int fq) const {
        const int p = u.pn; const int rowb = u.pm * BM + wr * 64 + fr;
        if (p < 4) {
#pragma unroll
            for (int ai = 0; ai < 2; ++ai)
#pragma unroll
                for (int m = 0; m < 4; ++m) { const int row = rowb + ai * HALF + m * 16; const float inv = row_inv(ss, row);
                    f32x4 o[2];
#pragma unroll
                    for (int n = 0; n < 2; ++n) { const f32x4 v = acc[ai][0][m][n] * inv, g = acc[ai][1][m][n] * inv;
#pragma unroll
                        for (int e = 0; e < 4; ++e) o[n][e] = v[e] * sigm(g[e]); }
                    *(u32x4*)(G + (size_t)row * 512 + p * 128 + wc * 32 + fq * 8) = pack8(o[0], o[1]); }
        } else if (p < 8) {
            const bool isq = p < 6; const float* gp = isq ? gq : gk; bf16_t* O = isq ? Q : K; const float sc = isq ? c2 : 1.0f; const int hh = 4 * (p & 1) + wc;
            f32x4 gv[2][2];
#pragma unroll
            for (int bj = 0; bj < 2; ++bj)
#pragma unroll
                for (int n = 0; n < 2; ++n) gv[bj][n] = *(const f32x4*)(gp + 32 * bj + 8 * fq + 4 * n) * sc;
#pragma unroll
            for (int ai = 0; ai < 2; ++ai)
#pragma unroll
                for (int m = 0; m < 4; ++m) { const int row = rowb + ai * HALF + m * 16; const float inv = row_inv(ss, row);
                    f32x4 a[2][2]; float s = 0.f;
#pragma unroll
                    for (int bj = 0; bj < 2; ++bj)
#pragma unroll
                        for (int n = 0; n < 2; ++n) { a[bj][n] = acc[ai][bj][m][n] * inv; s += (a[bj][n][0] * a[bj][n][0] + a[bj][n][1] * a[bj][n][1]) + (a[bj][n][2] * a[bj][n][2] + a[bj][n][3] * a[bj][n][3]); }
                    s += __shfl_xor(s, 16); s += __shfl_xor(s, 32);
                    const float rinv = __builtin_amdgcn_rsqf(s * (1.0f / 64.0f) + 1e-6f);
#pragma unroll
                    for (int bj = 0; bj < 2; ++bj)
                        *(u32x4*)(O + (size_t)row * 512 + hh * 64 + 32 * bj + 8 * fq) = pack8(a[bj][0] * rinv * gv[bj][0], a[bj][1] * rinv * gv[bj][1]); }
        } else if (p < 10) {
#pragma unroll
            for (int ai = 0; ai < 2; ++ai)
#pragma unroll
                for (int m = 0; m < 4; ++m) { const int row = rowb + ai * HALF + m * 16; const float inv = row_inv(ss, row);
#pragma unroll
                    for (int bj = 0; bj < 2; ++bj)
                        *(u32x4*)(V + (size_t)row * 512 + (p - 8) * 256 + bj * HALF + wc * 32 + fq * 8) = pack8(acc[ai][bj][m][0] * inv, acc[ai][bj][m][1] * inv); }
        } else {
            if (wc == 0 && fq == 0) {
#pragma unroll
                for (int ai = 0; ai < 2; ++ai)
#pragma unroll
                    for (int m = 0; m < 4; ++m) { const int row = rowb + ai * HALF + m * 16; const float inv = row_inv(ss, row); const int b = row >> 13, t = row & 8191;
#pragma unroll
                        for (int n = 0; n < 2; ++n)
#pragma unroll
                            for (int e = 0; e < 4; ++e) { const int h = 4 * n + e; const float z = acc[ai][0][m][n][e] * inv + bfg[h];
                                const float lf = fminf(z, 0.f) - __logf(1.0f + __expf(-fabsf(z)));
                                LF[(size_t)(b * 8 + h) * 8192 + t] = lf; } }
            }
        }
    }
};
struct EpiGatePair {
    static constexpr bool PERM = true, AFTER_DRAIN = false;
    bf16_t *GA, *GB; int apm_off;
    __device__ __forceinline__ void operator()(const f32x4 (&acc)[2][2][4][2], const Unit& u, int wr, int wc, int fr, int fq) const {
        const bool second = u.pn >= 4; const int pm = second ? u.pm + apm_off : u.pm, pn = second ? u.pn - 4 : u.pn;
        bf16_t* IO = second ? GB : GA;
        const int rowb = pm * BM + wr * 64 + fr, colb = pn * BM + wc * 32 + fq * 8;
#pragma unroll
        for (int ai = 0; ai < 2; ++ai)
#pragma unroll
            for (int m = 0; m < 4; ++m) { const int row = rowb + ai * HALF + m * 16;
#pragma unroll
                for (int bj = 0; bj < 2; ++bj) { const size_t off = (size_t)row * 1024 + colb + bj * HALF;
                    f32x4 g0, g1; unpack8(*(const u32x4*)(IO + off), g0, g1);
                    f32x4 o0 = g0 * acc[ai][bj][m][0], o1 = g1 * acc[ai][bj][m][1];
                    if (second) { f32x4 y0, y1; unpack8(*(const u32x4*)(GA + off), y0, y1); o0 += y0; o1 += y1; }
                    *(u32x4*)(IO + off) = pack8(o0, o1); } }
    }
};
struct PairOrder { StaticOrder s; int apm_off;
    __device__ __forceinline__ bool next(int i, Unit& u) const { if (i >= 2) return false; if (!s.next(0, u)) return false; if (i == 1) { u.pm -= apm_off; u.pn += 4; } return true; }
    __device__ __forceinline__ void a_ready(const Unit&) const {}
    __device__ __forceinline__ void done(const Unit&) const {} };
template <bool FINAL> struct EpiResid {
    static constexpr bool PERM = true, AFTER_DRAIN = false;
    float* Xout; bf16_t* XB; float* SS; bf16_t* XBo; float* SSo;
    __device__ __forceinline__ void operator()(const f32x4 (&acc)[2][2][4][2], const Unit& u, int wr, int wc, int fr, int fq) const {
        const int rowb = u.pm * BM + wr * 64 + fr, colb = u.pn * BM + wc * 32 + fq * 8;
#pragma unroll
        for (int ai = 0; ai < 2; ++ai)
#pragma unroll
            for (int m = 0; m < 4; ++m) { const int row = rowb + ai * HALF + m * 16; float s = 0.f;
#pragma unroll
                for (int bj = 0; bj < 2; ++bj) { const size_t off = (size_t)row * 1024 + colb + bj * HALF;
                    f32x4 x0, x1; unpack8(*(const u32x4*)(XB + off), x0, x1); x0 += acc[ai][bj][m][0]; x1 += acc[ai][bj][m][1];
                    if (FINAL) { __builtin_nontemporal_store(x0, (f32x4*)(Xout + off)); __builtin_nontemporal_store(x1, (f32x4*)(Xout + off + 4)); }
                    else { const u32x4 w = pack8(x0, x1); *(u32x4*)(XBo + off) = w; unpack8(w, x0, x1);
                        s += ((x0[0] * x0[0] + x0[1] * x0[1]) + (x0[2] * x0[2] + x0[3] * x0[3])) + ((x1[0] * x1[0] + x1[1] * x1[1]) + (x1[2] * x1[2] + x1[3] * x1[3])); } }
                if (!FINAL) { s += __shfl_xor(s, 16); s += __shfl_xor(s, 32);
                    if (fq == 0) SSo[(size_t)row * 16 + u.pn * 4 + wc] = s; } }
    }
};
struct EpiSwiglu {
    static constexpr bool PERM = true, AFTER_DRAIN = false;
    const float* ss; bf16_t* HB;
    __device__ __forceinline__ void operator()(const f32x4 (&acc)[2][2][4][2], const Unit& u, int wr, int wc, int fr, int fq) const {
        const int rowb = u.pm * BM + wr * 64 + fr;
#pragma unroll
        for (int ai = 0; ai < 2; ++ai)
#pragma unroll
            for (int m = 0; m < 4; ++m) { const int row = rowb + ai * HALF + m * 16; const float inv = row_inv(ss, row);
                f32x4 o[2];
#pragma unroll
                for (int n = 0; n < 2; ++n) { const f32x4 g = acc[ai][0][m][n] * inv, v = acc[ai][1][m][n] * inv;
#pragma unroll
                    for (int e = 0; e < 4; ++e) o[n][e] = g[e] * sigm(g[e]) * v[e]; }
                *(u32x4*)(HB + (size_t)row * 2816 + u.pn * 128 + wc * 32 + fq * 8) = pack8(o[0], o[1]); }
    }
};

template <class Epi, class Sched, bool ALIGN_EPI = false, bool SP2 = false>
__device__ __forceinline__ void gemm_phase(PG8_LAS unsigned char* lds, const Gemm g, const Sched& S, const Epi& E) {
    int tid = threadIdx.x; asm volatile("" : "+v"(tid));
    const int wid = __builtin_amdgcn_readfirstlane(tid >> 6), lane = tid & 63, wr = wid >> 2, wc = wid & 3, fr = lane & 15, fq = lane >> 4;
    const int K = g.K, nt = K / BK;
    unsigned voffA[2], voffB[2];
#pragma unroll
    for (int i = 0; i < 2; ++i) { int R, C; stage_rc(tid * 16 + i * 8192, R, C); const int Rb = Epi::PERM ? ((R & ~31) + perm32(R & 31)) : R;
        voffA[i] = (unsigned)(R * K + C) * 2u; voffB[i] = (unsigned)(Rb * K + C) * 2u; }
    const size_t kstep = (size_t)(BK * 2);
    const size_t hstep = (size_t)HALF * K * 2;
    const size_t tstep = 2 * hstep;
    const unsigned ldsw = (unsigned)wid * 1024u;
    const int aoff = lds_byte(wr * 64 + fr, fq * 8), boff = lds_byte(wc * 32 + fr, fq * 8);
#define PG8_SA(b, h) (((b) * 2 + (h)) * HTB)
#define PG8_SB(b, h) ((4 + (b) * 2 + (h)) * HTB)
#define PG8_STAGE(bufoff, gbase, voff) do { _Pragma("unroll") for (int _i = 0; _i < 2; ++_i) \
        __builtin_amdgcn_global_load_lds((const unsigned*)((const char*)(gbase) + (voff)[_i]), (PG8_LAS unsigned*)(lds + (bufoff) + ldsw + _i * 8192), 16, 0, 0); } while (0)
#define PG8_LDA(dst, b, h) do { _Pragma("unroll") for (int m = 0; m < 4; ++m) _Pragma("unroll") for (int k = 0; k < 2; ++k) dst[m][k] = *(const PG8_LAS bf16x8*)(lds + PG8_SA(b, h) + aoff + m * 2048 + k * 1024); } while (0)
#define PG8_LDB(dst, b, h) do { _Pragma("unroll") for (int n = 0; n < 2; ++n) _Pragma("unroll") for (int k = 0; k < 2; ++k) dst[n][k] = *(const PG8_LAS bf16x8*)(lds + PG8_SB(b, h) + boff + n * 2048 + k * 1024); } while (0)
#define PG8_MMA(ai, bj, At, Bt) do { __builtin_amdgcn_s_setprio(1); _Pragma("unroll") for (int m = 0; m < 4; ++m) _Pragma("unroll") for (int n = 0; n < 2; ++n) _Pragma("unroll") for (int k = 0; k < 2; ++k) \
        acc[ai][bj][m][n] = __builtin_amdgcn_mfma_f32_16x16x32_bf16(Bt[n][k], At[m][k], acc[ai][bj][m][n], 0, 0, 0); __builtin_amdgcn_s_setprio(0); } while (0)
#define PG8_WAIT_V(n) asm volatile("s_waitcnt vmcnt(" #n ")" ::: "memory")
#define PG8_WAIT_L(n) asm volatile("s_waitcnt lgkmcnt(" #n ")" ::: "memory")
#define PG8_BAR __builtin_amdgcn_s_barrier()
#define PG8_SCHED __builtin_amdgcn_sched_barrier(0)
    Unit cur, nxt; int ui = 0;
    if (!S.next(0, cur)) return;
    f32x4 acc[2][2][4][2];
#pragma unroll
    for (int a = 0; a < 2; ++a)
#pragma unroll
        for (int b = 0; b < 2; ++b)
#pragma unroll
            for (int m = 0; m < 4; ++m)
#pragma unroll
                for (int n = 0; n < 2; ++n) acc[a][b][m][n] = (f32x4){0.f, 0.f, 0.f, 0.f};
    bf16x8 At[4][2], B0[2][2], B1[2][2];
    const char* cA = (const char*)g.A + (size_t)cur.pm * tstep; const char* cB = (const char*)g.Bt + (size_t)cur.pn * tstep;
    S.a_ready(cur);
    if constexpr (SP2) {
        PG8_STAGE(PG8_SB(0, 0), cB, voffB); PG8_STAGE(PG8_SB(0, 1), cB + hstep, voffB); PG8_STAGE(PG8_SA(0, 0), cA, voffA); PG8_STAGE(PG8_SA(0, 1), cA + hstep, voffA);
        if (wr == 1) PG8_BAR;
        PG8_WAIT_V(2); PG8_BAR;
        PG8_STAGE(PG8_SB(1, 0), cB + kstep, voffB); PG8_STAGE(PG8_SA(1, 0), cA + kstep, voffA); PG8_STAGE(PG8_SB(1, 1), cB + hstep + kstep, voffB);
        PG8_WAIT_V(6); PG8_BAR;
    } else {
        PG8_STAGE(PG8_SB(0, 0), cB, voffB); PG8_STAGE(PG8_SA(0, 0), cA, voffA); PG8_STAGE(PG8_SB(0, 1), cB + hstep, voffB); PG8_STAGE(PG8_SA(0, 1), cA + hstep, voffA);
        if (wr == 1) PG8_BAR;
        PG8_WAIT_V(4); PG8_BAR;
        PG8_STAGE(PG8_SB(1, 0), cB + kstep, voffB); PG8_STAGE(PG8_SA(1, 0), cA + kstep, voffA); PG8_STAGE(PG8_SB(1, 1), cB + hstep + kstep, voffB);
        PG8_WAIT_V(6); PG8_BAR;
    }
    for (;;) {
        const bool has_next = S.next(ui + 1, nxt);
        const char* nA = has_next ? (const char*)g.A + (size_t)nxt.pm * tstep : cA; const char* nB = has_next ? (const char*)g.Bt + (size_t)nxt.pn * tstep : cB;
        for (int t = 0; t < nt; t += 2) {
            const bool last = (t == nt - 2);
            const char* a1 = cA + (size_t)(t + 1) * kstep;
            const char* a2 = last ? nA : cA + (size_t)(t + 2) * kstep; const char* b2 = last ? nB : cB + (size_t)(t + 2) * kstep;
            const char* a3 = a2 + kstep; const char* b3 = b2 + kstep;
            if (last && has_next) S.a_ready(nxt);
            if constexpr (SP2) {
            PG8_LDB(B0, 0, 0); PG8_LDB(B1, 0, 1); PG8_SCHED; PG8_LDA(At, 0, 0); PG8_STAGE(PG8_SA(1, 1), a1 + hstep, voffA);
            PG8_WAIT_V(8); PG8_WAIT_L(0); PG8_BAR; PG8_MMA(0, 0, At, B0); PG8_MMA(0, 1, At, B1); PG8_BAR; PG8_SCHED;
            PG8_LDA(At, 0, 1); PG8_STAGE(PG8_SB(0, 0), b2, voffB); PG8_STAGE(PG8_SB(0, 1), b2 + hstep, voffB); PG8_STAGE(PG8_SA(0, 0), a2, voffA);
            PG8_WAIT_V(8); PG8_WAIT_L(0); PG8_BAR; PG8_MMA(1, 0, At, B0); PG8_MMA(1, 1, At, B1); PG8_BAR; PG8_SCHED;
            PG8_LDB(B0, 1, 0); PG8_LDB(B1, 1, 1); PG8_SCHED; PG8_LDA(At, 1, 0); PG8_STAGE(PG8_SA(0, 1), a2 + hstep, voffA);
            PG8_WAIT_V(8); PG8_WAIT_L(0); PG8_BAR; PG8_MMA(0, 0, At, B0); PG8_MMA(0, 1, At, B1); PG8_BAR; PG8_SCHED;
            PG8_LDA(At, 1, 1); PG8_STAGE(PG8_SB(1, 0), b3, voffB); PG8_STAGE(PG8_SB(1, 1), b3 + hstep, voffB); PG8_STAGE(PG8_SA(1, 0), a3, voffA);
            PG8_WAIT_V(8); PG8_WAIT_L(0); PG8_BAR; PG8_MMA(1, 0, At, B0); PG8_MMA(1, 1, At, B1); PG8_BAR; PG8_SCHED;
            } else {
            PG8_LDB(B0, 0, 0); PG8_SCHED; PG8_LDA(At, 0, 0); PG8_STAGE(PG8_SA(1, 1), a1 + hstep, voffA);
            PG8_WAIT_L(8); PG8_BAR; PG8_WAIT_L(0); PG8_MMA(0, 0, At, B0); PG8_BAR; PG8_SCHED;
            PG8_LDB(B1, 0, 1); PG8_STAGE(PG8_SB(0, 0), b2, voffB);
            PG8_BAR; PG8_WAIT_L(0); PG8_MMA(0, 1, At, B1); PG8_BAR;
            PG8_LDA(At, 0, 1); PG8_STAGE(PG8_SA(0, 0), a2, voffA);
            PG8_BAR; PG8_WAIT_L(0); PG8_MMA(1, 0, At, B0); PG8_BAR; PG8_SCHED;
            PG8_STAGE(PG8_SB(0, 1), b2 + hstep, voffB);
            PG8_WAIT_V(6); PG8_BAR; PG8_MMA(1, 1, At, B1); PG8_BAR;
            PG8_LDB(B0, 1, 0); PG8_SCHED; PG8_LDA(At, 1, 0); PG8_STAGE(PG8_SA(0, 1), a2 + hstep, voffA);
            PG8_WAIT_L(8); PG8_BAR; PG8_WAIT_L(0); PG8_MMA(0, 0, At, B0); PG8_BAR; PG8_SCHED;
            PG8_LDB(B1, 1, 1); PG8_STAGE(PG8_SB(1, 0), b3, voffB);
            PG8_BAR; PG8_WAIT_L(0); PG8_MMA(0, 1, At, B1); PG8_BAR;
            PG8_LDA(At, 1, 1); PG8_STAGE(PG8_SA(1, 0), a3, voffA);
            PG8_BAR; PG8_WAIT_L(0); PG8_MMA(1, 0, At, B0); PG8_BAR; PG8_SCHED;
            PG8_STAGE(PG8_SB(1, 1), b3 + hstep, voffB);
            PG8_WAIT_V(6); PG8_BAR; PG8_MMA(1, 1, At, B1); PG8_BAR;
            }
        }
        if constexpr (ALIGN_EPI) { if (wr == 0) PG8_BAR; }
        if constexpr (!Epi::AFTER_DRAIN) { E(acc, cur, wr, wc, fr, fq); S.done(cur); }
        if (!has_next) break;
#pragma unroll
        for (int a = 0; a < 2; ++a)
#pragma unroll
            for (int b = 0; b < 2; ++b)
#pragma unroll
                for (int m = 0; m < 4; ++m)
#pragma unroll
                    for (int n = 0; n < 2; ++n) acc[a][b][m][n] = (f32x4){0.f, 0.f, 0.f, 0.f};
        cur = nxt; cA = nA; cB = nB; ++ui;
        if constexpr (ALIGN_EPI) { if (wr == 1) PG8_BAR; }
    }
    PG8_WAIT_V(0);
    if constexpr (!ALIGN_EPI) { if (wr == 0) PG8_BAR; }
    PG8_BAR;
    if constexpr (Epi::AFTER_DRAIN) { E.fused(acc, cur, wr, wc, fr, fq, lds, wid, lane); S.done(cur); }
#undef PG8_SA
#undef PG8_SB
#undef PG8_STAGE
#undef PG8_LDA
#undef PG8_LDB
#undef PG8_MMA
#undef PG8_WAIT_V
#undef PG8_WAIT_L
#undef PG8_BAR
#undef PG8_SCHED
}
}

#ifndef PG8_SP2
#define PG8_SP2 true
#endif
#ifndef PG8_ALIGN
#define PG8_ALIGN true
#endif
#include <hip/hip_bf16.h>
#include <cmath>
namespace attn_body {
using bf16=__hip_bfloat16;
using bf16x8=__attribute__((ext_vector_type(8)))short;
using s16x4=__attribute__((ext_vector_type(4)))short;
using f32x16=__attribute__((ext_vector_type(16)))float;
using u32x4=__attribute__((ext_vector_type(4)))unsigned;
constexpr int BATCH=2,NHEAD=8,SEQ=8192,D=64,DM=NHEAD*D;
constexpr int NW=8,QBLK=32,QB=QBLK*NW,KVBLK=64,NQB=SEQ/QB;
constexpr int ATTN_PITCH=DM, ATTN_UNIT_ROWS=QB;
__device__ __forceinline__ int crow(int r,int hi){return (r&3)+8*(r>>2)+4*hi;}
#define SBAR() __builtin_amdgcn_sched_barrier(0)
__device__ __forceinline__ void cmask(f32x16&p0,f32x16&p1,int jb,int qrel,int hi){
  const float NEG=-INFINITY; int kb=64*jb+4*hi;
  #pragma unroll
  for(int r=0;r<16;++r){int kv=kb+(r&3)+8*(r>>2); if(kv>qrel)p0[r]=NEG; if(kv+32>qrel)p1[r]=NEG;}
}

constexpr int NSLOT=3, SLOTB=8192;
constexpr int LDS_K=0, LDS_V=NSLOT*SLOTB, LDS_WS=2*NSLOT*SLOTB, LDS_OST=LDS_WS+NW*64*4, LDS_CL=86016, LDS_BYTES=LDS_CL+SEQ*4;
constexpr float C2=0.125f*1.4426950408889634f;
__device__ __forceinline__ void glds16(const void*gsrc,unsigned lds_dst){unsigned keep;
  asm volatile("s_mov_b32 %0, m0\n\ts_mov_b32 m0, %2\n\ts_nop 0\n\tglobal_load_lds_dwordx4 %1, off\n\ts_mov_b32 m0, %0":"=&s"(keep):"v"(gsrc),"s"(lds_dst):"memory");}
__device__ __forceinline__ float max3f(float a,float b,float c){float r;asm("v_max3_f32 %0, %1, %2, %3":"=v"(r):"v"(a),"v"(b),"v"(c));return r;}
__device__ __forceinline__ float max2f(float a,float b){float r;asm("v_max_f32_e32 %0, %1, %2":"=v"(r):"v"(a),"v"(b));return r;}
__device__ __forceinline__ float fadd_s(float a,float b){float r;asm("v_add_f32_e32 %0, %1, %2":"=v"(r):"v"(a),"v"(b));return r;}
__device__ __forceinline__ float fsub_s(float a,float b){float r;asm("v_sub_f32_e32 %0, %1, %2":"=v"(r):"v"(a),"v"(b));return r;}
typedef float f32x2_t __attribute__((ext_vector_type(2))); typedef __bf16 bf16x2_t __attribute__((ext_vector_type(2)));
__device__ __forceinline__ unsigned cvtpk_s(float lo,float hi){f32x2_t v={lo,hi};bf16x2_t b=__builtin_convertvector(v,bf16x2_t);return __builtin_bit_cast(unsigned,b);}
#define WAIT_BAR(N) asm volatile("s_waitcnt vmcnt(" #N ") lgkmcnt(0)\n\ts_barrier":::"memory")

__device__ __forceinline__ void qkt(f32x16&p0,f32x16&p1,const char*Kslot,const bf16x8*qr,int r32,int hi){
  const char*kb=Kslot+hi*1024+r32*16;
  #pragma unroll
  for(int d0=0;d0<4;++d0){
    const bf16x8 b0=*reinterpret_cast<const bf16x8*>(kb+d0*2048);
    const bf16x8 b1=*reinterpret_cast<const bf16x8*>(kb+d0*2048+512);
    p0=__builtin_amdgcn_mfma_f32_32x32x16_bf16(b0,qr[d0],p0,0,0,0);p1=__builtin_amdgcn_mfma_f32_32x32x16_bf16(b1,qr[d0],p1,0,0,0);}
}
typedef __attribute__((address_space(3))) const char* lds_cptr;
typedef short v4i16_t __attribute__((ext_vector_type(4)));
__device__ __forceinline__ void kload8(bf16x8*kf,lds_cptr kp){
  kf[0]=*(const __attribute__((address_space(3))) bf16x8*)(kp);      kf[1]=*(const __attribute__((address_space(3))) bf16x8*)(kp+512);
  kf[2]=*(const __attribute__((address_space(3))) bf16x8*)(kp+2048); kf[3]=*(const __attribute__((address_space(3))) bf16x8*)(kp+2560);
  kf[4]=*(const __attribute__((address_space(3))) bf16x8*)(kp+4096); kf[5]=*(const __attribute__((address_space(3))) bf16x8*)(kp+4608);
  kf[6]=*(const __attribute__((address_space(3))) bf16x8*)(kp+6144); kf[7]=*(const __attribute__((address_space(3))) bf16x8*)(kp+6656);
}
__device__ __forceinline__ void kload2(bf16x8*kf,lds_cptr kp,int j){ kf[2*j]=*(const __attribute__((address_space(3))) bf16x8*)(kp+j*2048); kf[2*j+1]=*(const __attribute__((address_space(3))) bf16x8*)(kp+j*2048+512); }
__device__ __forceinline__ s16x4 vtr(lds_cptr p){ return __builtin_bit_cast(s16x4,__builtin_amdgcn_ds_read_tr16_b64_v4i16((__attribute__((address_space(3))) v4i16_t*)p)); }
__device__ __forceinline__ float rowmax(const f32x16&p0,const f32x16&p1){
  float a=max3f(p0[0],p0[1],p1[0]),b=max3f(p0[2],p0[3],p1[1]);a=max3f(a,p1[2],p1[3]);
  #pragma unroll
  for(int r=4;r<16;r+=4){a=max3f(a,p0[r],p0[r+1]);b=max3f(b,p0[r+2],p0[r+3]);a=max3f(a,p1[r],p1[r+1]);b=max3f(b,p1[r+2],p1[r+3]);}
  const float m=max2f(a,b);
  auto rr=__builtin_amdgcn_permlane32_swap(__float_as_uint(m),__float_as_uint(m),false,false);
  return max2f(__uint_as_float(rr[0]),__uint_as_float(rr[1]));
}
__device__ __forceinline__ void pv(f32x16*o,int vb,bf16x8 pa0,bf16x8 pa1,bf16x8 pa2,bf16x8 pa3){
  #pragma unroll
  for(int d0=0;d0<2;++d0){s16x4 lo[4],hi[4];
    #pragma unroll
    for(int ks=0;ks<4;++ks){
      asm volatile("ds_read_b64_tr_b16 %0,%1 offset:%c2":"=&v"(lo[ks]):"v"(vb),"i"(d0*4096+ks*1024):"memory");
      asm volatile("ds_read_b64_tr_b16 %0,%1 offset:%c2":"=&v"(hi[ks]):"v"(vb),"i"(d0*4096+ks*1024+512):"memory");}
    asm volatile("s_waitcnt lgkmcnt(0)":::"memory");SBAR();
    #define PK(k) (bf16x8){lo[k][0],lo[k][1],lo[k][2],lo[k][3],hi[k][0],hi[k][1],hi[k][2],hi[k][3]}
    o[d0]=__builtin_amdgcn_mfma_f32_32x32x16_bf16(pa0,PK(0),o[d0],0,0,0);
    o[d0]=__builtin_amdgcn_mfma_f32_32x32x16_bf16(pa1,PK(1),o[d0],0,0,0);
    o[d0]=__builtin_amdgcn_mfma_f32_32x32x16_bf16(pa2,PK(2),o[d0],0,0,0);
    o[d0]=__builtin_amdgcn_mfma_f32_32x32x16_bf16(pa3,PK(3),o[d0],0,0,0);
    #undef PK
  }
}

#ifndef ATTN_STORE16
#define ATTN_STORE16(p,v) (*(u32x4*)(p)=(v))
#endif
template<int THRL> __device__ __forceinline__ void attn_unit(int b,int h,int qb,const bf16*Q,const bf16*__restrict__ K,const bf16*__restrict__ V,bf16*O,const float*__restrict__ CLg,const float*__restrict__ GQg,const float*__restrict__ GKg,char*shm){
  int tid=threadIdx.x; asm volatile("":"+v"(tid)); const int lane=tid&63,r32=lane&31,hi=lane>>5; const int wid=__builtin_amdgcn_readfirstlane(tid>>6);
  const long rowbase=(long)b*SEQ; const int q0=qb*QB;
  const bf16*Qw=Q+(rowbase+q0+wid*QBLK)*DM+h*D;
  const lds_cptr shm3=(lds_cptr)shm;
  const unsigned lds0=(unsigned)(uintptr_t)shm;
  float*wsf=(float*)(shm+LDS_WS)+wid*64;
  typedef __attribute__((address_space(3))) float lds_f32; typedef float f32x4_t __attribute__((ext_vector_type(4)));
  lds_f32* const cl3=(lds_f32*)(shm3+LDS_CL);
  bf16x8 qr[4];
  #pragma unroll
  for(int d0=0;d0<4;++d0)qr[d0]=__builtin_nontemporal_load(reinterpret_cast<const bf16x8*>(&Qw[(long)r32*DM+d0*16+hi*8]));
  const float mq0_=GQg[lane],mk0_=GKg[lane];
  { const float*cg=CLg+((long)(b*NHEAD+h))*SEQ;
    const int n_=q0+QB; f32x4_t v_[4]; float run_=0.f;
    if(tid*16<n_){
      #pragma unroll
      for(int j_=0;j_<4;++j_)v_[j_]=*(const f32x4_t*)(cg+tid*16+4*j_);
      #pragma unroll
      for(int j_=0;j_<4;++j_){
        #pragma unroll
        for(int e_=0;e_<4;++e_){run_+=v_[j_][e_];v_[j_][e_]=run_;} } }
    float inc_=run_;
    #pragma unroll
    for(int o_=1;o_<64;o_<<=1){ const float y_=__shfl_up(inc_,o_); if(lane>=o_)inc_+=y_; }
    lds_f32* const wt_=(lds_f32*)(shm3+LDS_WS);
    if(lane==63)wt_[wid]=inc_;
    asm volatile("s_waitcnt vmcnt(0) lgkmcnt(0)\n\ts_barrier":::"memory");
    float off_=inc_-run_;
    for(int w_=0;w_<wid;++w_)off_+=wt_[w_];
    if(tid*16<n_){
      #pragma unroll
      for(int j_=0;j_<4;++j_)*(__attribute__((address_space(3))) f32x4_t*)(cl3+tid*16+4*j_)=(v_[j_]+off_)*1.4426950408889634f; }
    asm volatile("s_waitcnt vmcnt(0) lgkmcnt(0)\n\ts_barrier":::"memory"); }
  int t_start=0; bool chk_=true;
  { float mq=fabsf(mq0_),mk=fabsf(mk0_);
    #pragma unroll
    for(int o_=1;o_<64;o_<<=1){ mq=fmaxf(mq,__shfl_xor(mq,o_)); mk=fmaxf(mk,__shfl_xor(mk,o_)); }
    const float thr=-(40.0f+2.0f*8.0f*1.4426950408889634f*mq*mk), cq0=cl3[q0]; const int kmax=(q0+QB)/KVBLK/2-2; int kk=0;
    #pragma unroll
    for(int st_=32;st_>=1;st_>>=1){ const int c_=kk+st_; if(c_<=kmax){ if(cq0-cl3[128*c_-1]<thr)kk=c_; } }
    t_start=__builtin_amdgcn_readfirstlane(2*kk);
    chk_=__builtin_amdgcn_readfirstlane((int)!(8.0f*1.4426950408889634f*mq*mk*1.01f<(float)THRL-0.5f))!=0; }
  const int NT=(q0+QB)/KVBLK-t_start;
  lds_f32* const cl3t=cl3+t_start*KVBLK;
  const bf16*Kh=K+(rowbase+(long)t_start*KVBLK)*DM+h*D,*Vh=V+(rowbase+(long)t_start*KVBLK)*DM+h*D;
  const float cli=cl3[q0+wid*QBLK+r32];
  const bf16*ksrc=Kh+(long)lane*DM+wid*8;
  const bf16*vsrc=Vh+(long)(16*(wid&3)+(lane>>2))*DM+(wid>>2)*32+(lane&3)*8;
  const unsigned kdst=lds0+LDS_K+wid*1024, vdst=lds0+LDS_V+wid*1024;
  #define DMA_K(t,slot) glds16(ksrc+(long)(t)*KVBLK*DM,(unsigned)__builtin_amdgcn_readfirstlane(kdst+(slot)))
  #define DMA_V(t,slot) glds16(vsrc+(long)(t)*KVBLK*DM,(unsigned)__builtin_amdgcn_readfirstlane(vdst+(slot)))
  const int vb0=(int)(lds0+LDS_V)+((lane>>4)&1)*32+(lane&3)*8+(4*hi+((lane&15)>>2))*64;
  const char*Kbase=shm+LDS_K; bf16x8 kf[8];
  const lds_cptr kp0=shm3+LDS_K+hi*1024+r32*16; const lds_cptr vp0=shm3+LDS_V+((lane>>4)&1)*32+(lane&3)*8+(4*hi+((lane&15)>>2))*64;
  #define BIASFILL(X0,X1,t) do{ const lds_f32* cp_=cl3t+(t)*KVBLK+4*hi; const float bs_=cli-mhat; \
    _Pragma("unroll") for(int g_=0;g_<4;++g_){ const f32x4_t a_=*(const __attribute__((address_space(3))) f32x4_t*)(cp_+8*g_); const f32x4_t b_=*(const __attribute__((address_space(3))) f32x4_t*)(cp_+32+8*g_); \
      _Pragma("unroll") for(int e_=0;e_<4;++e_){ X0[4*g_+e_]=bs_-a_[e_]; X1[4*g_+e_]=bs_-b_[e_]; } } }while(0)
  DMA_K(0,0);DMA_V(0,0);DMA_K(1,SLOTB);
  float mhat=0.f,l_reg=0.f;f32x16 o[2];o[0]=f32x16{};o[1]=f32x16{};
  const int qrel=wid*QBLK+r32;
  #define CMASK(P0,P1,t) do{int jb_=(t)-(NT-4); if(jb_>=0)cmask(P0,P1,jb_,qrel,hi);}while(0)
  bool resc=false;
  #define START(P0,P1) do{ const float rm=rowmax(P0,P1); resc=false; \
    { const float dl=max2f(rm,0.f); mhat=fadd_s(mhat,dl); \
      _Pragma("unroll") for(int r=0;r<16;++r){P0[r]=fsub_s(P0[r],dl);P1[r]=fsub_s(P1[r],dl);} } \
    _Pragma("unroll") for(int r=0;r<16;++r)P0[r]=__builtin_amdgcn_exp2f(P0[r]); }while(0)
  #define RESC() do{ if(resc){ asm volatile("s_waitcnt lgkmcnt(0)":::"memory"); \
      _Pragma("unroll") for(int d_=0;d_<2;++d_) _Pragma("unroll") for(int r=0;r<16;++r)o[d_][r]*=wsf[crow(r,hi)]; } }while(0)
  f32x16 pA0,pA1,pB0,pB1;
  int sl_prev=0,sl_cur=0,sl_next=SLOTB;
  #define ROT() do{sl_prev=sl_cur;sl_cur=sl_next;sl_next=(sl_next==(NSLOT-1)*SLOTB)?0:sl_next+SLOTB;}while(0)
  DMA_K(2,2*SLOTB);
  WAIT_BAR(3);
  BIASFILL(pA0,pA1,0); qkt(pA0,pA1,Kbase,qr,r32,hi);asm volatile("s_nop 15\n\ts_nop 7":"+v"(pA0),"+v"(pA1));CMASK(pA0,pA1,0);
  START(pA0,pA1);
  _Pragma("unroll") for(int r=0;r<16;++r)pA1[r]=__builtin_amdgcn_exp2f(pA1[r]);
  BIASFILL(pB0,pB1,1);
  WAIT_BAR(0);
  DMA_K(3,0);DMA_V(1,SLOTB);
  ROT();
  kload8(kf,kp0+sl_cur);
  WAIT_BAR(2);
  s16x4 vlo[8],vhi[8]; u32x4 pw0,pw1,pw2,pw3;
  #define PKW(P,B) cvtpk_s(P[B],P[B+1])
  #define PAF(k) __builtin_bit_cast(bf16x8,pw##k)
  #define VFR(i) (bf16x8){vlo[i][0],vlo[i][1],vlo[i][2],vlo[i][3],vhi[i][0],vhi[i][1],vhi[i][2],vhi[i][3]}
  #define PIN(x) asm volatile("":"+v"(x))
  #define MX3(a,b,c) __builtin_fmaxf(__builtin_fmaxf((a),(b)),(c))
  #define GAPA(MF,A0,A1,A2,A3,W0,W1,PW) do{ MF; sacc+=A0; sacc+=A1; sacc+=A2; sacc+=A3; PIN(sacc); W0; W1; PIN(PW); SBAR(); }while(0)
  #define EX(v) __builtin_amdgcn_exp2f(v)
  #define GAPB(MF,X,B,GF_,Y,OFF) do{ MF; f32x4_t bl_; if(GF_){ bl_=*(const __attribute__((address_space(3))) f32x4_t*)(bcp_+(OFF)); } \
    X[B]=EX(X[B]); X[B+1]=EX(X[B+1]); X[B+2]=EX(X[B+2]); X[B+3]=EX(X[B+3]); PIN(X); \
    if(GF_){ Y[B]=bbs_-bl_[0]; Y[B+1]=bbs_-bl_[1]; Y[B+2]=bbs_-bl_[2]; Y[B+3]=bbs_-bl_[3]; PIN(Y); } SBAR(); }while(0)
  #define VRD(i) do{ vlo[i]=vtr(vp_+(((i)>>2)*4096+((i)&3)*1024)); vhi[i]=vtr(vp_+(((i)>>2)*4096+((i)&3)*1024+512)); }while(0)
  #define KRD(G,j) do{ if(G){ kload2(kf,kp0+sl_next,j); SBAR(); } }while(0)
  #define STEP(C0,C1,P0,P1,t,GK,GV,GL,GF) do{ SBAR(); \
    const lds_cptr vp_=vp0+sl_prev; \
    VRD(0); SBAR(); float sacc=(P0[0]+P0[1]); \
    GAPA(C0=__builtin_amdgcn_mfma_f32_32x32x16_bf16(kf[0],qr[0],C0,0,0,0), P0[2],P0[3],P0[4],P0[5],     pw0[0]=PKW(P0,0), pw0[1]=PKW(P0,2), pw0); \
    VRD(4); SBAR(); GAPA(C1=__builtin_amdgcn_mfma_f32_32x32x16_bf16(kf[1],qr[0],C1,0,0,0), P0[6],P0[7],P0[8],P0[9],     pw0[2]=PKW(P0,4), pw0[3]=PKW(P0,6), pw0); \
    VRD(1); SBAR(); GAPA(C0=__builtin_amdgcn_mfma_f32_32x32x16_bf16(kf[2],qr[1],C0,0,0,0),   P0[10],P0[11],P0[12],P0[13], pw1[0]=PKW(P0,8), pw1[1]=PKW(P0,10), pw1); \
    VRD(5); SBAR(); GAPA(C1=__builtin_amdgcn_mfma_f32_32x32x16_bf16(kf[3],qr[1],C1,0,0,0),   P0[14],P0[15],P1[0],P1[1],   pw1[2]=PKW(P0,12),pw1[3]=PKW(P0,14), pw1); \
    VRD(2); SBAR(); GAPA(C0=__builtin_amdgcn_mfma_f32_32x32x16_bf16(kf[4],qr[2],C0,0,0,0),   P1[2],P1[3],P1[4],P1[5],     pw2[0]=PKW(P1,0), pw2[1]=PKW(P1,2), pw2); \
    VRD(6); SBAR(); GAPA(C1=__builtin_amdgcn_mfma_f32_32x32x16_bf16(kf[5],qr[2],C1,0,0,0),   P1[6],P1[7],P1[8],P1[9],     pw2[2]=PKW(P1,4), pw2[3]=PKW(P1,6), pw2); \
    VRD(3); SBAR(); GAPA(C0=__builtin_amdgcn_mfma_f32_32x32x16_bf16(kf[6],qr[3],C0,0,0,0),   P1[10],P1[11],P1[12],P1[13], pw3[0]=PKW(P1,8), pw3[1]=PKW(P1,10), pw3); \
    VRD(7); SBAR(); GAPA(C1=__builtin_amdgcn_mfma_f32_32x32x16_bf16(kf[7],qr[3],C1,0,0,0),   P1[14],P1[15],0.f,0.f,       pw3[2]=PKW(P1,12),pw3[3]=PKW(P1,14), pw3); \
    l_reg+=sacc; \
    if(GK){DMA_K((t)+3,sl_cur);} if(GV){DMA_V((t)+1,sl_next);} \
    CMASK(C0,C1,t); \
    resc=false; \
    if(chk_){ float a=MX3(C0[0],C0[1],C1[0]),b=MX3(C0[2],C0[3],C1[1]); a=MX3(a,C1[2],C1[3]); \
      _Pragma("unroll") for(int r=4;r<16;r+=4){a=MX3(a,C0[r],C0[r+1]);b=MX3(b,C0[r+2],C0[r+3]);a=MX3(a,C1[r],C1[r+1]);b=MX3(b,C1[r+2],C1[r+3]);} \
      float rm=__builtin_fmaxf(a,b); { auto rr=__builtin_amdgcn_permlane32_swap(__float_as_uint(rm),__float_as_uint(rm),false,false); rm=__builtin_fmaxf(__uint_as_float(rr[0]),__uint_as_float(rr[1])); } \
      if(__builtin_expect(__any(rm>(float)THRL),0)){ const float dl=__builtin_fmaxf(rm,0.f); mhat+=dl; \
        _Pragma("unroll") for(int r=0;r<16;++r){C0[r]-=dl;C1[r]-=dl;} \
        const float f=__builtin_amdgcn_exp2f(-dl); l_reg*=f; if(hi==0)wsf[r32]=f; resc=true; } } \
    const lds_f32* const bcp_=cl3t+((t)+1)*KVBLK+4*hi; const float bbs_=cli-mhat; \
    SBAR(); \
    GAPB(o[0]=__builtin_amdgcn_mfma_f32_32x32x16_bf16(PAF(0),VFR(0),o[0],0,0,0), C0,0, GF,P0,0); \
    GAPB(o[1]=__builtin_amdgcn_mfma_f32_32x32x16_bf16(PAF(0),VFR(4),o[1],0,0,0), C0,4, GF,P0,8); \
    KRD(GL,0); GAPB(o[0]=__builtin_amdgcn_mfma_f32_32x32x16_bf16(PAF(1),VFR(1),o[0],0,0,0), C0,8, GF,P0,16); \
    KRD(GL,1); GAPB(o[1]=__builtin_amdgcn_mfma_f32_32x32x16_bf16(PAF(1),VFR(5),o[1],0,0,0), C0,12, GF,P0,24); \
    KRD(GL,2); GAPB(o[0]=__builtin_amdgcn_mfma_f32_32x32x16_bf16(PAF(2),VFR(2),o[0],0,0,0), C1,0, GF,P1,32); \
    KRD(GL,3); GAPB(o[1]=__builtin_amdgcn_mfma_f32_32x32x16_bf16(PAF(2),VFR(6),o[1],0,0,0), C1,4, GF,P1,40); \
    GAPB(o[0]=__builtin_amdgcn_mfma_f32_32x32x16_bf16(PAF(3),VFR(3),o[0],0,0,0), C1,8, GF,P1,48); \
    GAPB(o[1]=__builtin_amdgcn_mfma_f32_32x32x16_bf16(PAF(3),VFR(7),o[1],0,0,0), C1,12, GF,P1,56); \
    }while(0)
  int t=1;
  #undef CMASK
  #define CMASK(P0,P1,t) do{}while(0)
  for(;t+5<NT;t+=2){
    STEP(pB0,pB1,pA0,pA1,t,true,true,true,true);     WAIT_BAR(2); RESC(); ROT();
    STEP(pA0,pA1,pB0,pB1,t+1,true,true,true,true);   WAIT_BAR(2); RESC(); ROT();
  }
  #undef CMASK
  #define CMASK(P0,P1,t) do{int jb_=(t)-(NT-4); if(jb_>=0)cmask(P0,P1,jb_,qrel,hi);}while(0)
  #define ENDW(tt) do{ if((tt)+3<NT){WAIT_BAR(2);} else if((tt)+2<NT){WAIT_BAR(1);} else {WAIT_BAR(0);} }while(0)
  for(;t+1<NT;t+=2){
    STEP(pB0,pB1,pA0,pA1,t,(t+3<NT),(t+1<NT),(t+1<NT),true);       ENDW(t);   RESC(); ROT();
    STEP(pA0,pA1,pB0,pB1,t+1,(t+4<NT),(t+2<NT),(t+2<NT),true);     ENDW(t+1); RESC(); ROT();
  }
  STEP(pB0,pB1,pA0,pA1,NT-1,false,false,false,false); RESC();
  { float sacc=pB0[0]+pB0[1]; _Pragma("unroll") for(int r=2;r<16;++r)sacc+=pB0[r]; _Pragma("unroll") for(int r=0;r<16;++r)sacc+=pB1[r]; l_reg+=sacc;
    pw0=(u32x4){PKW(pB0,0),PKW(pB0,2),PKW(pB0,4),PKW(pB0,6)};pw1=(u32x4){PKW(pB0,8),PKW(pB0,10),PKW(pB0,12),PKW(pB0,14)};pw2=(u32x4){PKW(pB1,0),PKW(pB1,2),PKW(pB1,4),PKW(pB1,6)};pw3=(u32x4){PKW(pB1,8),PKW(pB1,10),PKW(pB1,12),PKW(pB1,14)};
    SBAR(); pv(o,vb0+sl_cur,PAF(0),PAF(1),PAF(2),PAF(3)); }
  #undef PKW
  #undef PAF
  #undef VFR
  #undef PIN
  #undef MX3
  #undef GAPA
  #undef GAPB
  #undef EX
  #undef VRD
  #undef KRD
  #undef STEP
  #undef ENDW
  {auto rr=__builtin_amdgcn_permlane32_swap(__float_as_uint(l_reg),__float_as_uint(l_reg),false,false);l_reg=__uint_as_float(rr[0])+__uint_as_float(rr[1]);}
  if(hi==0)wsf[32+r32]=l_reg;asm volatile("s_waitcnt lgkmcnt(0)":::"memory");
  float rli[16];
  #pragma unroll
  for(int r=0;r<16;++r)rli[r]=__builtin_amdgcn_rcpf(wsf[32+crow(r,hi)]);
  bf16*Ow=O+(rowbase+q0+wid*QBLK)*DM+h*D;
  { bf16*stg=(bf16*)(shm+LDS_OST)+wid*2048;
    #pragma unroll
    for(int r=0;r<16;++r){const int orow=crow(r,hi);
      #pragma unroll
      for(int d0=0;d0<2;++d0)stg[orow*64+d0*32+r32]=__float2bfloat16(o[d0][r]*rli[r]);}
    asm volatile("s_waitcnt lgkmcnt(0)":::"memory");
    #pragma unroll
    for(int i=0;i<4;++i){const int row=i*8+(lane>>3),ch=lane&7; const u32x4 v=*(const u32x4*)(stg+row*64+ch*8); ATTN_STORE16(Ow+(long)row*DM+ch*8,v);} }
  asm volatile("s_waitcnt lgkmcnt(0)\n\ts_barrier":::"memory");
  #undef DMA_K
  #undef DMA_V
  #undef CMASK
  #undef START
  #undef RESC
  #undef ROT
  #undef BIASFILL
}
constexpr int ATTN_LDS_BYTES=LDS_BYTES;
struct AttnTensors { const bf16* Q; const bf16* K; const bf16* V; bf16* O; const float* CL; const float* GQ; const float* GK; };
struct AttnUnit { int bh; int qb; };
struct StaticOrder {
  int vcu,G;
  __device__ __forceinline__ explicit StaticOrder(int grid,int block):vcu((grid%8==0)?(block%8)*(grid/8)+block/8:block),G(grid){}
  __device__ __forceinline__ bool next(int i,AttnUnit&u)const{ const int p=vcu+G*(i>>1); if(p>=BATCH*NHEAD*NQB/2)return false; const int s=p&15; u.bh=p>>4; u.qb=(i&1)?31-s:s; return true; }
  __device__ __forceinline__ void a_ready(const AttnUnit&)const{}
  __device__ __forceinline__ void done(const AttnUnit&)const{}
};
template<class Sched,int THRL=16> __device__ __forceinline__ void attn_phase(char*lds,const AttnTensors&T,const Sched&S){
  AttnUnit u;
  for(int i=0;S.next(i,u);++i){ S.a_ready(u); attn_unit<THRL>(u.bh/NHEAD,u.bh%NHEAD,u.qb,T.Q,T.K,T.V,T.O,T.CL,T.GQ,T.GK,lds); S.done(u); }
}
template<int THRL=16> __device__ __forceinline__ void attn_phase_dyn(char*lds,const AttnTensors&T,unsigned*cnt,volatile __attribute__((address_space(3))) int*word,int myq){
  for(;;){
    if(threadIdx.x==0){ int got=-1;
      for(int k=0;k<8&&got<0;++k){ const int q=(myq+k)&7; const unsigned idx=__hip_atomic_fetch_add(cnt+64*q,1u,__ATOMIC_RELAXED,__HIP_MEMORY_SCOPE_AGENT); if(idx<64u)got=q*64+(int)idx; }
      *word=got; }
    __syncthreads();
    const int j=__builtin_amdgcn_readfirstlane(*word);
    if(j<0)break;
    const int q=j>>6,k=j&63,bh=2*q+(k&1),qb=31-(k>>1);
    attn_unit<THRL>(bh/NHEAD,bh%NHEAD,qb,T.Q,T.K,T.V,T.O,T.CL,T.GQ,T.GK,lds);
  }
  __syncthreads();
}
#undef SBAR
#undef WAIT_BAR
}
#include <hip/hip_cooperative_groups.h>
namespace cg = cooperative_groups;
constexpr int NWAVES = 8;
#ifndef REP_P0
#define REP_P0 1
#endif
#ifndef REP_T
#define REP_T 1
#endif
#ifndef REP_P1
#define REP_P1 1
#endif
#ifndef REP_ATT
#define REP_ATT 1
#endif
#ifndef REP_GATES
#define REP_GATES 1
#endif
#ifndef REP_P7F
#define REP_P7F 1
#endif
#ifndef REP_I3
#define REP_I3 1
#endif
#ifndef REP_P5
#define REP_P5 1
#endif
#ifndef PG8_ALIGN1
#define PG8_ALIGN1 PG8_ALIGN
#endif
#ifndef GATE_TAKE
#define GATE_TAKE 2
#endif
#ifndef REP_P6
#define REP_P6 1
#endif
constexpr int BATCH = 2, T = 8192, D = 1024, M = BATCH * T, DEPTH = 2;
constexpr int CC = 512, CW = 31, NH = 8, FF = 2816, INC = 4616, NIN = 19 * 256;
constexpr size_t MiB = 1u << 20;
constexpr size_t W_STRIDE = 32 * MiB, W_IN = 0, W_C = 10 * MiB, W_A = 11 * MiB, W_O = 12 * MiB, W_F = 14 * MiB, W_D = 26 * MiB;
constexpr size_t WS_XB = 64 * MiB, WS_GA = 96 * MiB, WS_GB = 128 * MiB, WS_Q = 160 * MiB, WS_K = 176 * MiB, WS_V = 192 * MiB, WS_G = 208 * MiB, WS_AC = 224 * MiB,
                 WS_SS = 240 * MiB, WS_LF = 241 * MiB, WS_CL = 242 * MiB, WS_CTL = 243 * MiB, WS_END = 244 * MiB;
constexpr size_t WS_HB = 96 * MiB;
static_assert(WS_HB + (size_t)M * FF * 2 <= WS_V && W_F + (size_t)2 * FF * D * 2 <= W_D && W_D + (size_t)D * FF * 2 <= W_STRIDE && (size_t)NIN * D * 2 <= W_C, "d_ws map");
constexpr int RING_BYTES = 131072, LDS_BYTES = 135168, LDS_BARST = RING_BYTES + 64;
constexpr size_t CTL_ZERO_BYTES = 65536;

#define LAS __attribute__((address_space(3)))
typedef unsigned short bf16;
typedef unsigned v4u __attribute__((ext_vector_type(4)));
typedef float f32x4 __attribute__((ext_vector_type(4)));
typedef float f32x2 __attribute__((ext_vector_type(2)));
#define LDS_WAIT() asm volatile("s_waitcnt lgkmcnt(0)" ::: "memory")
__device__ __forceinline__ unsigned f2bf(float f) { unsigned u = __builtin_bit_cast(unsigned, f); return (u + 0x7fffu + ((u >> 16) & 1u)) >> 16; }
__device__ __forceinline__ unsigned pk2(float lo, float hi) { return f2bf(lo) | (f2bf(hi) << 16); }
__device__ __forceinline__ float wave_sum(float v) {
#pragma unroll
    for (int o = 1; o < 64; o <<= 1) v += __shfl_xor(v, o);
    return v;
}
__device__ __forceinline__ void tr_item(const float* W, int ldw, int K, bf16* WT, int kb, int orow0, int src0, int valid, const float* gk, LAS float* scr, int lane) {
    const int k0 = 64 * kb, c = lane & 31;
    float v[32], gsc[32];
    const bool ok = c < valid;
#pragma unroll
    for (int i = 0; i < 32; ++i) { const int kk = 2 * i + (lane >> 5); v[i] = ok ? __builtin_nontemporal_load(W + (size_t)(k0 + kk) * ldw + src0 + c) : 0.f;     gsc[i] = gk ? gk[k0 + kk] : 1.0f; }
#pragma unroll
    for (int i = 0; i < 32; ++i) { const int kk = 2 * i + (lane >> 5); scr[kk * 33 + c] = v[i] * gsc[i]; }
    LDS_WAIT(); asm volatile("" ::: "memory");
    const int ch = lane & 7;
#pragma unroll
    for (int j = 0; j < 4; ++j) { const int n = (lane >> 3) + 8 * j; const LAS float* s = scr + (8 * ch) * 33 + n;
        v4u o; o.x = pk2(s[0 * 33], s[1 * 33]); o.y = pk2(s[2 * 33], s[3 * 33]); o.z = pk2(s[4 * 33], s[5 * 33]); o.w = pk2(s[6 * 33], s[7 * 33]);
        *(v4u*)(WT + (size_t)(orow0 + n) * K + k0 + 8 * ch) = o; }
    LDS_WAIT(); asm volatile("" ::: "memory");
}
__device__ __forceinline__ int src_in(int ob, int& valid) {
    const int p = ob >> 3, sub = ob & 7; valid = 32;
    if (p < 4) return sub < 4 ? 128 * p + 32 * sub : 512 + 128 * p + 32 * (sub - 4);
    if (p < 8) { const int base = p < 6 ? 1024 : 1536, hh = 4 * (p & 1) + (sub & 3), bj = sub >> 2; return base + hh * 64 + 32 * bj; }
    if (p < 10) return 2048 + 256 * (p - 8) + 32 * sub;
    if (p == 10) { if (sub == 0) { valid = 8; return 2560; } valid = 0; return 0; }
    if (p < 15) return 2568 + 256 * (p - 11) + 32 * sub;
    return 3592 + 256 * (p - 15) + 32 * sub;
}
__device__ __forceinline__ int src_ffn(int ob) { const int p = ob >> 3, sub = ob & 7; return sub < 4 ? 128 * p + 32 * sub : FF + 128 * p + 32 * (sub - 4); }

#define XB_TMO      128
#define XB_XCNT(j)  (256  + 64 * (j))
#define XB_XSUB(j)  (1280 + 64 * (j))
#define XB_XGEN(j)  (2304 + 64 * (j))
#define XB_TOP      3328
#define XB_TOPGEN   3392
#define XCD_BAR_WORDS 3456
#define XB_SPIN_CAP (1u << 18)

__device__ __forceinline__ unsigned xb_ld(unsigned* p)              { return __hip_atomic_load(p, __ATOMIC_RELAXED, __HIP_MEMORY_SCOPE_AGENT); }
__device__ __forceinline__ unsigned xb_add(unsigned* p, unsigned v) { return __hip_atomic_fetch_add(p, v, __ATOMIC_RELAXED, __HIP_MEMORY_SCOPE_AGENT); }
__device__ __forceinline__ unsigned xb_xcc_id() { return (unsigned)__builtin_amdgcn_s_getreg((3 << 11) | 20) & 0xFu; }
#define XB_SPIN(cond, bar) do { unsigned _sp = 0; while (cond) { __builtin_amdgcn_s_sleep(1); \
    if ((++_sp & 255u) == 0u) { if (xb_ld(&(bar)[XB_TMO])) break; if (_sp > XB_SPIN_CAP) { atomicAdd(&(bar)[XB_TMO], 1u); break; } } } } while (0)

struct XcdBarrier {
    unsigned* bar; unsigned x;
    volatile LAS unsigned* st;
};

__device__ __forceinline__ XcdBarrier xcd_barrier_post(unsigned* bar, volatile LAS unsigned* st) {
    XcdBarrier b; b.bar = bar; b.x = xb_xcc_id(); b.st = st;
    if (threadIdx.x == 0) (void)xb_add(&bar[XB_XCNT(b.x)], 1u);
    return b;
}
__device__ __forceinline__ void xcd_barrier_complete(unsigned* bar, unsigned x, unsigned& nloc, unsigned& nx) {
    const unsigned G = gridDim.x * gridDim.y * gridDim.z;
    unsigned sum, cnt, mine, sp = 0u;
    for (;;) {
        sum = 0u; cnt = 0u; mine = 0u;
#pragma unroll
        for (unsigned j = 0; j < 16; ++j) { const unsigned c = xb_ld(&bar[XB_XCNT(j)]); sum += c; cnt += (c > 0u) ? 1u : 0u; mine = (j == x) ? c : mine; }
        if (sum == G) break;
        __builtin_amdgcn_s_sleep(1);
        if ((++sp & 255u) == 0u) { if (xb_ld(&bar[XB_TMO])) break; if (sp > XB_SPIN_CAP) { atomicAdd(&bar[XB_TMO], 1u); break; } }
    }
    nloc = mine > 0u ? mine : 1u; nx = cnt > 0u ? cnt : 1u;
}

__device__ __forceinline__ void xcd_barrier(const XcdBarrier& b) {
    asm volatile("s_waitcnt vmcnt(0)" ::: "memory");
    __syncthreads();
    if (threadIdx.x == 0) {
        unsigned* bar = b.bar;
        __builtin_amdgcn_s_waitcnt(0);
        unsigned nloc = b.st[0], nx = b.st[1];
        if (nloc == 0u) { xcd_barrier_complete(bar, b.x, nloc, nx); b.st[0] = nloc; b.st[1] = nx; }
        const unsigned old = xb_add(&bar[XB_XSUB(b.x)], 1u);
        const unsigned gen = old / nloc;
        if (old + 1u == (gen + 1u) * nloc) {
            __builtin_amdgcn_fence(__ATOMIC_RELEASE, "agent");
            asm volatile("s_waitcnt vmcnt(0)" ::: "memory");
            const unsigned og = xb_add(&bar[XB_TOP], 1u);
            const unsigned tg = og / nx;
            if (og + 1u == (tg + 1u) * nx) xb_add(&bar[XB_TOPGEN], 1u);
            else XB_SPIN(xb_ld(&bar[XB_TOPGEN]) == tg, bar);
            __builtin_amdgcn_fence(__ATOMIC_ACQUIRE, "agent");
            xb_add(&bar[XB_XGEN(b.x)], 1u);
            asm volatile("s_waitcnt vmcnt(0)" ::: "memory");
        } else {
            XB_SPIN(xb_ld(&bar[XB_XGEN(b.x)]) == gen, bar);
            __builtin_amdgcn_fence(__ATOMIC_ACQUIRE, "agent");
            asm volatile("s_waitcnt vmcnt(0)" ::: "memory");
        }
    }
    __syncthreads();
}

struct Args { const float* in[16]; float* out; unsigned char* ws; };

__device__ __forceinline__ void scan_seq(LAS unsigned char* lds, int tid, const float* lf, float* cl) {
    const int lane = tid & 63, wave = tid >> 6;
    f32x4 v[4];
#pragma unroll
    for (int j = 0; j < 4; ++j) v[j] = *(const f32x4*)(lf + tid * 16 + 4 * j);
    float run = 0.f;
#pragma unroll
    for (int j = 0; j < 4; ++j)
#pragma unroll
        for (int e = 0; e < 4; ++e) { run += v[j][e]; v[j][e] = run; }
    float inc = run;
#pragma unroll
    for (int o = 1; o < 64; o <<= 1) { const float y = __shfl_up(inc, o); if (lane >= o) inc += y; }
    LAS float* wt = (LAS float*)lds;
    if (lane == 63) wt[wave] = inc;
    __syncthreads();
    float off = inc - run;
    for (int w = 0; w < wave; ++w) off += wt[w];
#pragma unroll
    for (int j = 0; j < 4; ++j) { *(f32x4*)(cl + tid * 16 + 4 * j) = (v[j] + off) * 1.4426950408889634f; }
    __syncthreads();
}

#define XB_LSUB(j)  (3584 + 64 * (j))
#define XB_LGEN(j)  (4608 + 64 * (j))
#define XB_RMAXA(r) (5696 + 64 * (r))
#define XB_RMAXB(r) (6208 + 64 * (r))
__device__ __forceinline__ void xcd_local_barrier(const XcdBarrier& b, unsigned nloc) {
    asm volatile("s_waitcnt vmcnt(0)" ::: "memory");
    __syncthreads();
    if (threadIdx.x == 0) {
        unsigned* bar = b.bar;
        const unsigned old = xb_add(&bar[XB_LSUB(b.x)], 1u);
        const unsigned gen = old / nloc;
        if (old + 1u == (gen + 1u) * nloc) xb_add(&bar[XB_LGEN(b.x)], 1u);
        else XB_SPIN(xb_ld(&bar[XB_LGEN(b.x)]) == gen, bar);
        __builtin_amdgcn_fence(__ATOMIC_ACQUIRE, "agent");
        asm volatile("s_waitcnt vmcnt(0)" ::: "memory");
    }
    __syncthreads();
}
struct OneUnit { int q, k0, n;
    __device__ __forceinline__ bool next(int i, pg8::Unit& u) const { if (i >= n) return false; const int k = k0 + i; u.pm = 8 * q + (k & 7); u.pn = k >> 3; return true; }
    __device__ __forceinline__ void a_ready(const pg8::Unit&) const {}
    __device__ __forceinline__ void done(const pg8::Unit&) const {} };
__device__ __forceinline__ int claim_unit(unsigned* cnt, int myq, int per_q, volatile LAS int* word, unsigned take = 1u) {
    if (threadIdx.x == 0) { int got = -1;
        for (int k = 0; k < 8 && got < 0; ++k) { const int q = (myq + k) & 7; const unsigned idx = __hip_atomic_fetch_add(cnt + 64 * q, take, __ATOMIC_RELAXED, __HIP_MEMORY_SCOPE_AGENT); if (idx < (unsigned)per_q) got = q * per_q + (int)idx; }
        *word = got; }
    __syncthreads();
    const int j = __builtin_amdgcn_readfirstlane(*word);
    __syncthreads();
    return j;
}
__device__ __forceinline__ void conv_phase(LAS unsigned char* lds, unsigned* cnt, int myq, volatile LAS int* word, int tid, const bf16* Gin, const float* wdw, const float* bdw, const float* gln, const float* bln, bf16* AC) {
    LAS unsigned* lin = (LAS unsigned*)lds;
    LAS float* lout = (LAS float*)(lds + 63488);
    const int lane = tid & 63, wave = tid >> 6, cp = tid & 255, th = tid >> 8;
    f32x2 wv[31];
#pragma unroll
    for (int k = 0; k < 31; ++k) wv[k] = *(const f32x2*)(wdw + k * 512 + 2 * cp);
    const f32x2 bb = *(const f32x2*)(bdw + 2 * cp);
    const f32x4 g0 = *(const f32x4*)(gln + 8 * lane), g1 = *(const f32x4*)(gln + 8 * lane + 4), b0 = *(const f32x4*)(bln + 8 * lane), b1 = *(const f32x4*)(bln + 8 * lane + 4);
    for (;;) {
        const int pass = claim_unit(cnt, myq, (M / 32) / 8, word); if (pass < 0) break;
        const int m0 = pass * 32, tb = m0 & (T - 1);
        for (int c = tid; c < 62 * 64; c += NWAVES * 64) { const int r = c >> 6, ch = c & 63; v4u v = (v4u){0u, 0u, 0u, 0u};
            if (tb - 30 + r >= 0) v = *(const v4u*)(Gin + (size_t)(m0 - 30 + r) * 512 + ch * 8);
            *(LAS v4u*)(lin + r * 256 + ch * 4) = v; }
        __syncthreads();
        f32x2 av[16];
#pragma unroll
        for (int o = 0; o < 16; ++o) av[o] = bb;
#pragma unroll
        for (int r = 0; r < 46; ++r) { const unsigned v = lin[(16 * th + r) * 256 + cp]; const f32x2 xv = (f32x2){__uint_as_float(v << 16), __uint_as_float(v & 0xffff0000u)};
#pragma unroll
            for (int o = 0; o < 16; ++o) { const int k = r - o; if (k >= 0 && k < 31) av[o] = __builtin_elementwise_fma(wv[k], xv, av[o]); } }
#pragma unroll
        for (int o = 0; o < 16; ++o) *(LAS f32x2*)(lout + (16 * th + o) * 512 + 2 * cp) = av[o];
        __syncthreads();
#pragma unroll
        for (int i = 0; i < 4; ++i) { const int tok = 4 * wave + i;
            f32x4 x0 = *(const LAS f32x4*)(lout + tok * 512 + 8 * lane), x1 = *(const LAS f32x4*)(lout + tok * 512 + 8 * lane + 4);
            const float mean = wave_sum(((x0[0] + x0[1]) + (x0[2] + x0[3])) + ((x1[0] + x1[1]) + (x1[2] + x1[3]))) * (1.0f / 512.0f);
            x0 = x0 - mean; x1 = x1 - mean;
            const float var = wave_sum(((x0[0] * x0[0] + x0[1] * x0[1]) + (x0[2] * x0[2] + x0[3] * x0[3])) + ((x1[0] * x1[0] + x1[1] * x1[1]) + (x1[2] * x1[2] + x1[3] * x1[3]))) * (1.0f / 512.0f);
            const float rstd = __builtin_amdgcn_rsqf(var + 1e-6f);
            x0 = x0 * rstd * g0 + b0; x1 = x1 * rstd * g1 + b1;
#pragma unroll
            for (int e = 0; e < 4; ++e) { x0[e] = x0[e] * pg8::sigm(x0[e]); x1[e] = x1[e] * pg8::sigm(x1[e]); }
            *(pg8::u32x4*)(AC + (size_t)(m0 + tok) * 512 + 8 * lane) = pg8::pack8(x0, x1); }
        __syncthreads();
    }
}
constexpr int I_IN = (D / 64) * (NIN / 32), I_C = (CC / 64) * (D / 32), I_O = (D / 64) * (D / 32), I_F = (D / 64) * (2 * FF / 32), I_D = (FF / 64) * (D / 32);
constexpr int I_L = I_IN + 2 * I_C + I_O + I_F + I_D, W_ITEMS = I_L;
__device__ __forceinline__ void weight_item(const Args& args, unsigned char* ws, int it, LAS float* scr, int lane) {
            const int l = it / I_L; int r = it % I_L; unsigned char* wl = ws + (size_t)l * W_STRIDE;
            if (r < I_IN) { const int nblk = NIN / 32, kb = r / nblk, ob = r % nblk; int valid; const int s0 = src_in(ob, valid);
                tr_item(args.in[2] + (size_t)l * D * INC, INC, D, (bf16*)(wl + W_IN), kb, 32 * ob, s0, valid, args.in[1] + l * D, scr, lane); return; } r -= I_IN;
            if (r < I_C) { const int nblk = D / 32, kb = r / nblk, ob = r % nblk;
                tr_item(args.in[8] + (size_t)l * CC * D, D, CC, (bf16*)(wl + W_C), kb, 32 * ob, 32 * ob, 32, nullptr, scr, lane); return; } r -= I_C;
            if (r < I_C) { const int nblk = D / 32, kb = r / nblk, ob = r % nblk;
                tr_item(args.in[11] + (size_t)l * CC * D, D, CC, (bf16*)(wl + W_A), kb, 32 * ob, 32 * ob, 32, nullptr, scr, lane); return; } r -= I_C;
            if (r < I_O) { const int nblk = D / 32, kb = r / nblk, ob = r % nblk;
                tr_item(args.in[12] + (size_t)l * D * D, D, D, (bf16*)(wl + W_O), kb, 32 * ob, 32 * ob, 32, nullptr, scr, lane); return; } r -= I_O;
            if (r < I_F) { const int nblk = 2 * FF / 32, kb = r / nblk, ob = r % nblk;
                tr_item(args.in[14] + (size_t)l * D * 2 * FF, 2 * FF, D, (bf16*)(wl + W_F), kb, 32 * ob, src_ffn(ob), 32, args.in[13] + l * D, scr, lane); return; } r -= I_F;
            { const int nblk = D / 32, kb = r / nblk, ob = r % nblk;
                tr_item(args.in[15] + (size_t)l * FF * D, D, FF, (bf16*)(wl + W_D), kb, 32 * ob, 32 * ob, 32, nullptr, scr, lane); }
}

__global__ void __launch_bounds__(NWAVES * 64, 2) fwd_kernel(Args args) {
    extern __shared__ __attribute__((aligned(16))) unsigned char lds_raw[];
    cg::grid_group grid = cg::this_grid();
    LAS unsigned char* lds = (LAS unsigned char*)lds_raw;
    if (threadIdx.x < 2) ((volatile LAS unsigned*)(lds + LDS_BARST))[threadIdx.x] = 0u;
    __syncthreads();
    const XcdBarrier bar = xcd_barrier_post((unsigned*)(args.ws + WS_CTL), (volatile LAS unsigned*)(lds + LDS_BARST));
    if (threadIdx.x == 0) { unsigned* cw = (unsigned*)(args.ws + WS_CTL); __hip_atomic_fetch_max(cw + XB_RMAXA(blockIdx.x & 7u), bar.x + 1u, __ATOMIC_RELAXED, __HIP_MEMORY_SCOPE_AGENT); __hip_atomic_fetch_max(cw + XB_RMAXB(blockIdx.x & 7u), 16u - bar.x, __ATOMIC_RELAXED, __HIP_MEMORY_SCOPE_AGENT); }
    if (args.ws == nullptr) grid.sync();
#define GRID_SYNC() xcd_barrier(bar)
    const int tid = threadIdx.x, lane = tid & 63, wave = __builtin_amdgcn_readfirstlane(tid >> 6);
    const int G = gridDim.x, bx = blockIdx.x, vcu = (G % 8 == 0) ? (bx % 8) * (G / 8) + bx / 8 : bx;
    unsigned char* ws = args.ws;
    const float* x = args.in[0]; float* out = args.out;
    bf16* XB = (bf16*)(ws + WS_XB); bf16* GA = (bf16*)(ws + WS_GA); bf16* GB = (bf16*)(ws + WS_GB); bf16* Qb = (bf16*)(ws + WS_Q); bf16* Kb = (bf16*)(ws + WS_K); bf16* Vb = (bf16*)(ws + WS_V);
    bf16* Gb = (bf16*)(ws + WS_G); bf16* AC = (bf16*)(ws + WS_AC); bf16* HB = (bf16*)(ws + WS_HB);
    float* SS = (float*)(ws + WS_SS); float* LF = (float*)(ws + WS_LF); float* CL = (float*)(ws + WS_CL);

    for (int rep0 = 0; rep0 < REP_P0; ++rep0) {
        int tidP = threadIdx.x; asm volatile("" : "+v"(tidP)); const int lane = tidP & 63;
        LAS float* scr = (LAS float*)(lds + wave * 16384);
        const int gw = vcu * NWAVES + wave, NGW = G * NWAVES;
        const bool split = (G == 256);
        for (int it = gw; it < (split ? W_ITEMS : DEPTH * W_ITEMS); it += NGW) weight_item(args, ws, it, scr, lane);
        for (int m0 = gw; m0 < M; m0 += 4 * NGW) {
            f32x4 v[4][4];
#pragma unroll
            for (int r = 0; r < 4; ++r) { const int m = m0 + r * NGW; if (m < M) { const f32x4* xr = (const f32x4*)(x + (size_t)m * D) + lane;
#pragma unroll
                for (int j = 0; j < 4; ++j) v[r][j] = __builtin_nontemporal_load(xr + 64 * j); } }
#pragma unroll
            for (int r = 0; r < 4; ++r) { const int m = m0 + r * NGW; if (m < M) { float s = 0.f;
#pragma unroll
                for (int j = 0; j < 4; ++j) s += (v[r][j][0] * v[r][j][0] + v[r][j][1] * v[r][j][1]) + (v[r][j][2] * v[r][j][2] + v[r][j][3] * v[r][j][3]);
                s = wave_sum(s);
                unsigned long long* o8 = (unsigned long long*)(XB + (size_t)m * D) + lane;
#pragma unroll
                for (int j = 0; j < 4; ++j) o8[64 * j] = (unsigned long long)pk2(v[r][j][0], v[r][j][1]) | ((unsigned long long)pk2(v[r][j][2], v[r][j][3]) << 32);
                if (lane < 16) SS[(size_t)m * 16 + lane] = lane == 0 ? s : 0.f; } }
        }
    }
    GRID_SYNC();
    if (threadIdx.x == 0) { unsigned* cw = (unsigned*)(args.ws + WS_CTL); int bad = (gridDim.x != 256u);
        for (unsigned r = 0; r < 8; ++r) bad |= (xb_ld(cw + XB_RMAXA(r)) + xb_ld(cw + XB_RMAXB(r)) != 17u);
        for (unsigned j = 0; j < 16; ++j) { const unsigned c = xb_ld(cw + XB_XCNT(j)); bad |= (c != 0u && c != 32u); }
        *(volatile LAS int*)(lds + LDS_BARST + 48) = bad; }
    __syncthreads();
    const bool aligned = __builtin_amdgcn_readfirstlane(*(volatile LAS int*)(lds + LDS_BARST + 48)) == 0;
#define SEAM_LOCAL() do { if (aligned) xcd_local_barrier(bar, 32u); else xcd_barrier(bar); } while (0)
#ifdef PROBE_ALIGNED
    if (!aligned) for (int eb = 0; eb < 20; ++eb) GRID_SYNC();
#endif

    for (int l = 0; l < DEPTH; ++l) {
        unsigned char* wl = ws + (size_t)l * W_STRIDE;
        for (int rep1 = 0; rep1 < REP_P1; ++rep1) {
            pg8::Gemm g{XB, (const bf16*)(wl + W_IN), M, 11 * 256, D}; pg8::StaticOrder S; S.init(M, 11 * 256, G, bx);
            pg8::EpiInProj E{SS, Gb, Qb, Kb, Vb, LF, args.in[9] + l * 64, args.in[10] + l * 64, args.in[3] + l * NH, attn_body::C2};
            pg8::gemm_phase<pg8::EpiInProj, pg8::StaticOrder, PG8_ALIGN, PG8_SP2>(lds, g, S, E);
        }
        for (int stage = 0; stage < 2; ++stage) {
            if (stage == 1) {
                GRID_SYNC();
                const attn_body::AttnTensors AT{(const attn_body::bf16*)Qb, (const attn_body::bf16*)Kb, (const attn_body::bf16*)Vb, (attn_body::bf16*)Qb, LF, args.in[9] + l * 64, args.in[10] + l * 64};
                attn_body::attn_phase_dyn((char*)lds_raw, AT, (unsigned*)(args.ws + WS_CTL) + 8192 + l * 1024, (volatile LAS int*)(lds + LDS_BARST + 32), (int)bar.x & 7);
            }
#ifndef STAGE0_GATES
#define STAGE0_GATES 1
#endif
            int budget = stage == 0 ? ((G == 256 && bx >= 192) ? STAGE0_GATES : 0) : (1 << 30);
            while (budget-- > 0) {
                const unsigned take = stage == 0 ? 1u : (unsigned)GATE_TAKE;
                const int j = claim_unit((unsigned*)(args.ws + WS_CTL) + 8192 + 512 + l * 1024, (int)bar.x & 7, 64, (volatile LAS int*)(lds + LDS_BARST + 32), take);
                if (j < 0) break;
                const int q = j >> 6, k = j & 63, nu = (64 - k) < (int)take ? (64 - k) : (int)take;
                pg8::Gemm g{XB, (const bf16*)(wl + W_IN) + (size_t)11 * 256 * D, M, 8 * 256, D}; const OneUnit S{q, k, nu};
                pg8::EpiGateSig E{SS, GA, GB};
                pg8::gemm_phase<pg8::EpiGateSig, OneUnit, PG8_ALIGN, PG8_SP2>(lds, g, S, E);
            }
            if (stage == 1) {
                int tidT = threadIdx.x; asm volatile("" : "+v"(tidT));
                conv_phase(lds, (unsigned*)(args.ws + WS_CTL) + 8192 + 2048 + l * 1024, (int)bar.x & 7, (volatile LAS int*)(lds + LDS_BARST + 32), tidT, Gb, args.in[4] + (size_t)l * CW * CC, args.in[5] + l * CC, args.in[6] + l * CC, args.in[7] + l * CC, AC);
            }
        }
        GRID_SYNC();
        {
            static_assert((WS_AC - WS_Q) % ((size_t)256 * CC * 2) == 0 && W_A == W_C + (size_t)D * CC * 2, "the pair order reaches O and the attn-out weights through unit indices");
            constexpr int APM_OFF = (int)((WS_AC - WS_Q) / ((size_t)256 * CC * 2));
            pg8::Gemm g{AC, (const bf16*)(wl + W_C), M, D, CC}; pg8::PairOrder S; S.s.init(M, D, G, bx); S.apm_off = APM_OFF;
            pg8::EpiGatePair E{GA, GB, APM_OFF};
            pg8::gemm_phase<pg8::EpiGatePair, pg8::PairOrder, PG8_ALIGN, PG8_SP2>(lds, g, S, E);
        }
        SEAM_LOCAL();
        {
            pg8::Gemm g{GB, (const bf16*)(wl + W_O), M, D, D}; pg8::StaticOrder S; S.init(M, D, G, bx);
            for (int rep5 = 0; rep5 < REP_P5; ++rep5) { const bool lastr = rep5 + 1 == REP_P5;
            pg8::EpiResid<false> E{out, XB, SS, lastr ? XB : (bf16*)out, lastr ? SS : out + (size_t)M * D / 2};
            pg8::gemm_phase<pg8::EpiResid<false>, pg8::StaticOrder, PG8_ALIGN1, PG8_SP2>(lds, g, S, E); }
        }
        GRID_SYNC();
        for (int rep6 = 0; rep6 < REP_P6; ++rep6) {
            pg8::Gemm g{XB, (const bf16*)(wl + W_F), M, 2 * FF, D}; pg8::StaticOrder S; S.init(M, 2 * FF, G, bx);
            pg8::EpiSwiglu E{SS, HB};
            pg8::gemm_phase<pg8::EpiSwiglu, pg8::StaticOrder, PG8_ALIGN, PG8_SP2>(lds, g, S, E);
#ifdef REP_P6_BAR
            if (rep6 + 1 < REP_P6) GRID_SYNC();
#endif
        }
        if (l == 0 && G == 256 && bx >= 128) {
            int tidW = threadIdx.x; asm volatile("" : "+v"(tidW));
            LAS float* scr = (LAS float*)(lds + wave * 16384);
            for (int it = W_ITEMS + (bx - 128) * NWAVES + wave; it < DEPTH * W_ITEMS; it += 128 * NWAVES) weight_item(args, ws, it, scr, tidW & 63);
        }
        SEAM_LOCAL();
        {
            pg8::Gemm g{HB, (const bf16*)(wl + W_D), M, D, FF}; pg8::StaticOrder S; S.init(M, D, G, bx);
            if (l + 1 < DEPTH) { pg8::EpiResid<false> E{out, XB, SS, XB, SS}; pg8::gemm_phase<pg8::EpiResid<false>, pg8::StaticOrder, PG8_ALIGN1, PG8_SP2>(lds, g, S, E); }
            else { for (int rep7 = 0; rep7 < REP_P7F; ++rep7) { pg8::EpiResid<true> E{out, XB, SS, XB, SS}; pg8::gemm_phase<pg8::EpiResid<true>, pg8::StaticOrder, PG8_ALIGN1, PG8_SP2>(lds, g, S, E); } }
        }
        if (l + 1 < DEPTH) GRID_SYNC();
#ifdef EXTRA_BARS
        for (int eb = 0; eb < EXTRA_BARS; ++eb) GRID_SYNC();
#endif
    }
}

extern "C" void kernel_launch(void* const* d_in, const int* in_sizes, int n_in, void* d_out, int out_size, void* d_ws, size_t ws_size, hipStream_t stream) {
    static int grid = 0;
    if (grid == 0) {
        if (n_in != 16 || in_sizes[0] != M * D || out_size != M * D || ws_size < WS_END) { fprintf(stderr, "kernel_launch: unexpected shapes (n_in %d, in0 %d, out %d, ws %zu)\n", n_in, n_in > 0 ? in_sizes[0] : -1, out_size, ws_size); grid = -1; return; }
        int dev = 0, cus = 0, per_cu = 0;
        if (hipGetDevice(&dev) != hipSuccess || hipDeviceGetAttribute(&cus, hipDeviceAttributeMultiprocessorCount, dev) != hipSuccess) { grid = -1; return; }
        if (hipFuncSetAttribute((const void*)fwd_kernel, hipFuncAttributeMaxDynamicSharedMemorySize, LDS_BYTES) != hipSuccess) { fprintf(stderr, "kernel_launch: hipFuncSetAttribute failed\n"); grid = -1; return; }
        if (hipOccupancyMaxActiveBlocksPerMultiprocessor(&per_cu, (const void*)fwd_kernel, NWAVES * 64, LDS_BYTES) != hipSuccess || per_cu < 1) { fprintf(stderr, "kernel_launch: occupancy query says %d\n", per_cu); per_cu = 1; }
        (void)hipGetLastError();
        grid = cus * 1;
        (void)per_cu;
    }
    if (grid < 0) return;
    if (hipMemsetAsync((char*)d_ws + WS_CTL, 0, CTL_ZERO_BYTES, stream) != hipSuccess) { fprintf(stderr, "kernel_launch: hipMemsetAsync failed\n"); return; }
    Args a{};
    for (int i = 0; i < 16; ++i) a.in[i] = (const float*)d_in[i];
    a.out = (float*)d_out; a.ws = (unsigned char*)d_ws;
    void* params[] = {&a};
    const hipError_t le = hipLaunchCooperativeKernel((const void*)fwd_kernel, dim3(grid), dim3(NWAVES * 64), params, LDS_BYTES, stream);
    if (le != hipSuccess) fprintf(stderr, "kernel_launch: cooperative launch failed: %s (grid %d)\n", hipGetErrorName(le), grid);
}
```
